# Optimizing an MI355X kernel written in HIP

```python
import jax, jax.numpy as jnp
from jax import lax
import numpy as np

D_MODEL = 1024
BATCH = 8
SEQ = 2048
DEPTH = 1
DEC_BATCH = 128
DEC_SEQ = 4
PAST_LEN = 16384
PAGE_SIZE = 128

N_HEADS_A = 4
DK_A = D_MODEL // 16
DV_A = D_MODEL // 8
LOW_RANK = 16
GATE_TAU = 16.0
N_HEADS_R = 4
DK_R = D_MODEL // 16
DV_R = D_MODEL // 8
ROPE_BASE = 10000.0
QK_A = N_HEADS_A * DK_A
V_A = N_HEADS_A * DV_A
QK_R = N_HEADS_R * DK_R
V_R = N_HEADS_R * DV_R
D_FF = ((8 * D_MODEL // 3) + 127) // 128 * 128
D_PLE = 256
CHUNK = 64
EPS = 1e-6
IN_SPLITS = (QK_A, QK_A, V_A, V_A, QK_R, QK_R, V_R, V_R, LOW_RANK, D_MODEL, D_MODEL)
IN_COLS = sum(IN_SPLITS)

kernel_name = "hybrid_gla_retention_macaron_step"


def _split_points():
    return [int(c) for c in np.cumsum(IN_SPLITS)[:-1]]


def _ret_log_decay():
    h = jnp.arange(N_HEADS_R, dtype=jnp.float32)
    return jnp.log1p(-jnp.exp2(-5.0 - h))


def rmsnorm(x, w):
    xf = x.astype(jnp.float32)
    y = xf * lax.rsqrt(jnp.mean(xf * xf, axis=-1, keepdims=True) + EPS)
    return (y * w).astype(x.dtype)


def group_rmsnorm(o, w, dtype):
    B, T, H, dv = o.shape
    y = o * lax.rsqrt(jnp.mean(o * o, axis=-1, keepdims=True) + EPS)
    return (y * w.reshape(H, dv)).reshape(B, T, H * dv).astype(dtype)


def swiglu(x, w_in, w_out):
    a, b = jnp.split(x @ w_in, 2, axis=-1)
    return (jax.nn.silu(a) * b) @ w_out


def rotary(x, pos):
    d = x.shape[-1]
    half = d // 2
    freq = ROPE_BASE ** (-jnp.arange(half, dtype=jnp.float32) / half)
    ang = pos.astype(jnp.float32)[:, None] * freq[None, :]
    cos = jnp.cos(ang)[None, :, None, :]
    sin = jnp.sin(ang)[None, :, None, :]
    x1 = x[..., :half].astype(jnp.float32)
    x2 = x[..., half:].astype(jnp.float32)
    return jnp.concatenate([x1 * cos - x2 * sin, x1 * sin + x2 * cos], axis=-1).astype(x.dtype)


def gated_linear_scan(q, k, v, log_decay, s0, chunk):
    B, T, H, dk = q.shape
    dv = v.shape[-1]
    dg = log_decay.shape[-1]
    n = T // chunk

    def to_chunks(a):
        return a.astype(jnp.float32).reshape(B, n, chunk, H, a.shape[-1]).transpose(1, 0, 3, 2, 4)

    causal = jnp.tril(jnp.ones((chunk, chunk), dtype=bool))[:, :, None]

    def step(s, inp):
        qc, kc, vc, gc = inp
        b = jnp.cumsum(gc, axis=2)
        b_last = b[:, :, -1:, :]
        diff = b[:, :, :, None, :] - b[:, :, None, :, :]
        decay = jnp.exp(jnp.where(causal, diff, -jnp.inf))
        if dg == 1:
            scores = jnp.einsum('bhid,bhjd->bhij', qc, kc) * decay[..., 0]
        else:
            scores = jnp.einsum('bhid,bhjd,bhijd->bhij', qc, kc, decay)
        o = jnp.einsum('bhij,bhjv->bhiv', scores, vc) + jnp.einsum('bhid,bhdv->bhiv', qc * jnp.exp(b), s)
        s_new = jnp.exp(b_last)[:, :, 0, :, None] * s + jnp.einsum('bhjd,bhjv->bhdv', kc * jnp.exp(b_last - b), vc)
        return s_new, o

    s_final, o = lax.scan(step, s0.astype(jnp.float32),
                          (to_chunks(q), to_chunks(k), to_chunks(v), to_chunks(log_decay)))
    o = o.transpose(1, 0, 3, 2, 4).reshape(B, T, H, dv)
    return o, s_final


def trunk_layer(x, p, s_gla0, s_ret0, pos,
                norm_ffn1, w_ffn1_in, w_ffn1_out, norm_mix, w_in, w_alpha_up, b_alpha,
                gn_gla, gn_ret, w_out, norm_ffn2, w_ffn2_in, w_ffn2_out,
                norm_ple, w_ple_gate, w_ple_proj):
    B, T, _ = x.shape
    chunk = CHUNK if T % CHUNK == 0 else T
    h = x + 0.5 * swiglu(rmsnorm(x, norm_ffn1), w_ffn1_in, w_ffn1_out)
    u = rmsnorm(h, norm_mix)
    qa, ka, va, ra, qr, kr, vr, gr, a_low, gate_a, gate_r = jnp.split(u @ w_in, _split_points(), axis=-1)
    qa = qa.reshape(B, T, N_HEADS_A, DK_A) * (DK_A ** -0.5)
    ka = ka.reshape(B, T, N_HEADS_A, DK_A)
    va = va.reshape(B, T, N_HEADS_A, DV_A)
    log_alpha = jax.nn.log_sigmoid((a_low @ w_alpha_up + b_alpha).astype(jnp.float32)) / GATE_TAU
    log_alpha = log_alpha.reshape(B, T, N_HEADS_A, DK_A)
    oa, s_gla = gated_linear_scan(qa, ka, va, log_alpha, s_gla0, chunk)
    oa = group_rmsnorm(oa, gn_gla, x.dtype) * jax.nn.silu(ra)
    qr = rotary(qr.reshape(B, T, N_HEADS_R, DK_R), pos)
    kr = rotary(kr.reshape(B, T, N_HEADS_R, DK_R), pos) * (DK_R ** -0.5)
    vr = vr.reshape(B, T, N_HEADS_R, DV_R)
    log_gamma = jnp.broadcast_to(_ret_log_decay()[None, None, :, None], (B, T, N_HEADS_R, 1))
    orr, s_ret = gated_linear_scan(qr, kr, vr, log_gamma, s_ret0, chunk)
    orr = group_rmsnorm(orr, gn_ret, x.dtype) * jax.nn.silu(gr)
    mix = jax.nn.sigmoid(gate_a) * (oa @ w_out[:V_A]) + jax.nn.sigmoid(gate_r) * (orr @ w_out[V_A:])
    h = h + mix
    h = h + 0.5 * swiglu(rmsnorm(h, norm_ffn2), w_ffn2_in, w_ffn2_out)
    h = h + (p @ w_ple_proj) * jax.nn.sigmoid(rmsnorm(h, norm_ple) @ w_ple_gate)
    return h, s_gla, s_ret


def setup_inputs(seed: int = 0) -> dict:
    key = jax.random.key(seed)
    ks = jax.random.split(key, 24)
    f32 = jnp.float32
    nrm = lambda k, shape, s: jax.random.normal(k, shape, f32) * s
    gain = lambda k, n: 1.0 + 0.02 * jax.random.normal(k, (DEPTH, n), f32)
    return {
        "x_prompt": nrm(ks[0], (BATCH, SEQ, D_MODEL), 1.0),
        "x_sample": nrm(ks[1], (DEC_BATCH, DEC_SEQ, D_MODEL), 1.0),
        "state_gla": nrm(ks[2], (DEPTH, DEC_BATCH, N_HEADS_A, DK_A, DV_A), 0.5),
        "state_ret": nrm(ks[3], (DEPTH, DEC_BATCH, N_HEADS_R, DK_R, DV_R), 0.5),
        "p_prompt": nrm(ks[4], (DEPTH, BATCH, SEQ, D_PLE), 1.0),
        "p_sample": nrm(ks[5], (DEPTH, DEC_BATCH, DEC_SEQ, D_PLE), 1.0),
        "norm_ffn1": gain(ks[6], D_MODEL),
        "w_ffn1_in": nrm(ks[7], (DEPTH, D_MODEL, 2 * D_FF), D_MODEL ** -0.5),
        "w_ffn1_out": nrm(ks[8], (DEPTH, D_FF, D_MODEL), D_FF ** -0.5),
        "norm_mix": gain(ks[9], D_MODEL),
        "w_in": nrm(ks[10], (DEPTH, D_MODEL, IN_COLS), D_MODEL ** -0.5),
        "w_alpha_up": nrm(ks[11], (DEPTH, LOW_RANK, QK_A), LOW_RANK ** -0.5),
        "b_alpha": nrm(ks[12], (DEPTH, QK_A), 0.01),
        "gn_gla": gain(ks[13], V_A),
        "gn_ret": gain(ks[14], V_R),
        "w_out": nrm(ks[15], (DEPTH, V_A + V_R, D_MODEL), (V_A + V_R) ** -0.5),
        "norm_ffn2": gain(ks[16], D_MODEL),
        "w_ffn2_in": nrm(ks[17], (DEPTH, D_MODEL, 2 * D_FF), D_MODEL ** -0.5),
        "w_ffn2_out": nrm(ks[18], (DEPTH, D_FF, D_MODEL), D_FF ** -0.5),
        "norm_ple": gain(ks[19], D_MODEL),
        "w_ple_gate": nrm(ks[20], (DEPTH, D_MODEL, D_MODEL), D_MODEL ** -0.5),
        "w_ple_proj": nrm(ks[21], (DEPTH, D_PLE, D_MODEL), D_PLE ** -0.5),
        "norm_final": 1.0 + 0.02 * jax.random.normal(ks[22], (D_MODEL,), f32),
    }


def reference(x_prompt, x_sample, state_gla, state_ret, p_prompt, p_sample,
              norm_ffn1, w_ffn1_in, w_ffn1_out, norm_mix, w_in, w_alpha_up, b_alpha,
              gn_gla, gn_ret, w_out, norm_ffn2, w_ffn2_in, w_ffn2_out,
              norm_ple, w_ple_gate, w_ple_proj, norm_final):
    Bp, Tp, _ = x_prompt.shape
    Bs, Ts, _ = x_sample.shape
    pos_prompt = jnp.arange(Tp, dtype=jnp.int32)
    pos_sample = PAST_LEN + jnp.arange(Ts, dtype=jnp.int32)
    hp, hs = x_prompt, x_sample
    gla_p, ret_p, gla_s, ret_s = [], [], [], []
    for i in range(DEPTH):
        w = (norm_ffn1[i], w_ffn1_in[i], w_ffn1_out[i], norm_mix[i], w_in[i], w_alpha_up[i], b_alpha[i],
             gn_gla[i], gn_ret[i], w_out[i], norm_ffn2[i], w_ffn2_in[i], w_ffn2_out[i],
             norm_ple[i], w_ple_gate[i], w_ple_proj[i])
        zero_gla = jnp.zeros((Bp, N_HEADS_A, DK_A, DV_A), jnp.float32)
        zero_ret = jnp.zeros((Bp, N_HEADS_R, DK_R, DV_R), jnp.float32)
        hp, sa_p, sr_p = trunk_layer(hp, p_prompt[i], zero_gla, zero_ret, pos_prompt, *w)
        hs, sa_s, sr_s = trunk_layer(hs, p_sample[i], state_gla[i], state_ret[i], pos_sample, *w)
        gla_p.append(sa_p.astype(state_gla.dtype))
        ret_p.append(sr_p.astype(state_ret.dtype))
        gla_s.append(sa_s.astype(state_gla.dtype))
        ret_s.append(sr_s.astype(state_ret.dtype))
    y_prompt = rmsnorm(hp, norm_final)
    y_sample = rmsnorm(hs, norm_final)
    return (y_prompt, y_sample, jnp.stack(gla_p), jnp.stack(ret_p), jnp.stack(gla_s), jnp.stack(ret_s))
```

```cpp
#include <hip/hip_runtime.h>
#include <hip/hip_cooperative_groups.h>
#include <cstdio>
#include <cstdint>
namespace cg = cooperative_groups;
#ifndef MK_SINGLE
#define MK_SINGLE 1
#endif
constexpr int MP = 16384, MS = 512, MT = MP + MS, DM = 1024, FF = 2816, NQKV = 3328, DPLE = 256, WIN_N = 5136;
namespace pg8 {
#define PG8_LAS __attribute__((address_space(3)))
typedef unsigned short bf16_t;
typedef short bf16x8 __attribute__((ext_vector_type(8)));
typedef float f32x4 __attribute__((ext_vector_type(4)));
typedef unsigned u32x4 __attribute__((ext_vector_type(4)));
constexpr int BM = 256, BK = 64, HALF = 128, HTB = HALF * BK * 2  , STAGE_BYTES = 8 * HTB, NXCD = 8, WGM = 8;

__host__ __device__ __forceinline__ int lds_byte(int r, int c) { const int st = (r >> 4) * 2 + (c >> 5), rr = r & 15, cc = c & 31, ob = rr * 64 + cc * 2; return st * 1024 + (ob ^ (((ob >> 9) & 1) << 5)); }
__host__ __device__ __forceinline__ void stage_rc(int b, int& R, int& C) { const int st = b / 1024, sb = b % 1024, swz = sb ^ (((sb >> 9) & 1) << 5); R = (st >> 1) * 16 + swz / 64; C = (st & 1) * 32 + (swz % 64) / 2; }
__host__ __device__ __forceinline__ int perm32(int rho) { const int n = rho >> 4, i = rho & 15; return 8 * (i >> 2) + 4 * n + (i & 3); }

struct Unit { int pm, pn; };
struct Gemm { const bf16_t* A; const bf16_t* Bt; int M, N, K, lda, ldb; };

struct StaticOrder {
    int nM, nN, nwg, G, c;
    __host__ __device__ void init(int M, int N, int G_, int c_) { nM = M / BM; nN = N / BM; nwg = nM * nN; G = G_; c = c_; }
    __host__ __device__ bool next(int i, Unit& u) const {
        const long L = (long)i * G + c; if (L >= nwg) return false;
        int wgid = (int)L; { const int q = nwg / NXCD, r = nwg % NXCD, xcd = wgid % NXCD, off = wgid / NXCD; wgid = (xcd < r ? xcd * (q + 1) : r * (q + 1) + (xcd - r) * q) + off; }
        const int nig = WGM * nN, gid = wgid / nig, fm = gid * WGM, gsz = (nM - fm) < WGM ? (nM - fm) : WGM;
        u.pm = fm + ((wgid % nig) % gsz); u.pn = (wgid % nig) / gsz; return true;
    }
    __device__ __forceinline__ void a_ready(const Unit&) const {}
    __device__ __forceinline__ void done(const Unit&) const {}
};


__device__ __forceinline__ unsigned cvt_pk_bf16(float lo, float hi) { unsigned r; asm volatile("v_cvt_pk_bf16_f32 %0, %1, %2" : "=v"(r) : "v"(lo), "v"(hi)); return r; }
__device__ __forceinline__ u32x4 pack8(const f32x4 a, const f32x4 b) { u32x4 w; w.x = cvt_pk_bf16(a[0], a[1]); w.y = cvt_pk_bf16(a[2], a[3]); w.z = cvt_pk_bf16(b[0], b[1]); w.w = cvt_pk_bf16(b[2], b[3]); return w; }
__device__ __forceinline__ void unpack8(const u32x4 w, f32x4& a, f32x4& b) {
    a[0] = __uint_as_float(w.x << 16); a[1] = __uint_as_float(w.x & 0xffff0000u); a[2] = __uint_as_float(w.y << 16); a[3] = __uint_as_float(w.y & 0xffff0000u);
    b[0] = __uint_as_float(w.z << 16); b[1] = __uint_as_float(w.z & 0xffff0000u); b[2] = __uint_as_float(w.w << 16); b[3] = __uint_as_float(w.w & 0xffff0000u); }
__device__ __forceinline__ float sigm(float x) { return __builtin_amdgcn_rcpf(1.0f + __builtin_amdgcn_exp2f(-1.4426950408889634f * x)); }
__device__ __forceinline__ f32x4 sigm4(const f32x4 x) { f32x4 r; r[0] = sigm(x[0]); r[1] = sigm(x[1]); r[2] = sigm(x[2]); r[3] = sigm(x[3]); return r; }
__device__ __forceinline__ f32x4 silu4(const f32x4 x) { return x * sigm4(x); }
__device__ __forceinline__ float dot4(const f32x4 a) { return (a[0] * a[0] + a[1] * a[1]) + (a[2] * a[2] + a[3] * a[3]); }
__device__ __forceinline__ float row_rs(const float* rp, int row) {
    const f32x4 a = *(const f32x4*)(rp + ((size_t)0 * 16896 + row) * 4), b = *(const f32x4*)(rp + ((size_t)1 * 16896 + row) * 4), c = *(const f32x4*)(rp + ((size_t)2 * 16896 + row) * 4), d = *(const f32x4*)(rp + ((size_t)3 * 16896 + row) * 4);
    const float s = (((a[0] + a[1]) + (a[2] + a[3])) + ((b[0] + b[1]) + (b[2] + b[3]))) + (((c[0] + c[1]) + (c[2] + c[3])) + ((d[0] + d[1]) + (d[2] + d[3])));
    return rsqrtf(s * (1.0f / 1024.0f) + 1e-6f);
}

struct EpiSwiGLU {
    static constexpr bool PERM = true, AFTER_DRAIN = false;
    bf16_t* G; const float* rp;
    __device__ __forceinline__ void operator()(const f32x4 (&acc)[2][2][4][2], const Unit& u, int wr, int wc, int fr, int fq) const {
        const int row0 = u.pm * BM + wr * 64 + fr, col0 = u.pn * 128 + wc * 32 + 8 * fq;
#pragma unroll
        for (int ai = 0; ai < 2; ++ai)
#pragma unroll
            for (int m = 0; m < 4; ++m) { const int row = row0 + ai * HALF + m * 16; const float r = rp ? row_rs(rp, row) : 1.0f;
                const f32x4 g0 = silu4(acc[ai][0][m][0] * r) * (acc[ai][1][m][0] * r), g1 = silu4(acc[ai][0][m][1] * r) * (acc[ai][1][m][1] * r);
                *(u32x4*)(G + (size_t)row * 2816 + col0) = pack8(g0, g1); }
    }
};
struct EpiResid {
    static constexpr bool PERM = true, AFTER_DRAIN = false;
    const float* baseP; const float* baseS; float* H; bf16_t* XO; float* rp;
    __device__ __forceinline__ void operator()(const f32x4 (&acc)[2][2][4][2], const Unit& u, int wr, int wc, int fr, int fq) const {
        const int row0 = u.pm * BM + wr * 64 + fr, col0 = u.pn * BM + wc * 32 + 8 * fq;
#pragma unroll
        for (int ai = 0; ai < 2; ++ai)
#pragma unroll
            for (int m = 0; m < 4; ++m) { const int row = row0 + ai * HALF + m * 16;
                const float* bp = (row < 16384 ? baseP + (size_t)row * 1024 : baseS + (size_t)(row - 16384) * 1024) + col0; float ss = 0.f;
#pragma unroll
                for (int bj = 0; bj < 2; ++bj) { const f32x4 x0 = *(const f32x4*)(bp + bj * HALF), x1 = *(const f32x4*)(bp + bj * HALF + 4);
                    const f32x4 h0 = x0 + acc[ai][bj][m][0] * 0.5f, h1 = x1 + acc[ai][bj][m][1] * 0.5f; const size_t o = (size_t)row * 1024 + col0 + bj * HALF;
                    *(f32x4*)(H + o) = h0; *(f32x4*)(H + o + 4) = h1; *(u32x4*)(XO + o) = pack8(h0, h1); ss += dot4(h0) + dot4(h1); }
                ss += __shfl_xor(ss, 16); ss += __shfl_xor(ss, 32);
                if (fq == 0) rp[((size_t)u.pn * 16896 + row) * 4 + wc] = ss; }
    }
};
struct EpiQKV {
    static constexpr bool PERM = true, AFTER_DRAIN = false;
    bf16_t *QK, *V, *RG; float* AL; const float* rp; const float* b_alpha; const float* cosT; const float* sinT;
    __device__ __forceinline__ void operator()(const f32x4 (&acc)[2][2][4][2], const Unit& u, int wr, int wc, int fr, int fq) const {
        const int pn = u.pn; int mode = 0, cb = 0; bf16_t* dst = QK; float sc = 1.0f;
        if (pn == 0) { sc = 0.125f; } else if (pn == 1) { cb = 256; } else if (pn <= 3) { dst = V; cb = (pn - 2) * 256; } else if (pn <= 5) { mode = 1; dst = RG; cb = (pn - 4) * 256; }
        else if (pn == 6) { mode = 2; cb = 512; } else if (pn == 7) { mode = 2; cb = 768; sc = 0.125f; } else if (pn <= 9) { dst = V; cb = 512 + (pn - 8) * 256; }
        else if (pn <= 11) { mode = 1; dst = RG; cb = 512 + (pn - 10) * 256; } else { mode = 3; }
        const int row0 = u.pm * BM + wr * 64 + fr;
#pragma unroll
        for (int ai = 0; ai < 2; ++ai)
#pragma unroll
            for (int m = 0; m < 4; ++m) { const int row = row0 + ai * HALF + m * 16; const float r = row_rs(rp, row) * sc;
                if (mode <= 1) {
#pragma unroll
                    for (int bj = 0; bj < 2; ++bj) { f32x4 v0 = acc[ai][bj][m][0] * r, v1 = acc[ai][bj][m][1] * r; if (mode == 1) { v0 = silu4(v0); v1 = silu4(v1); }
                        *(u32x4*)(dst + (size_t)row * 1024 + cb + bj * HALF + wc * 32 + 8 * fq) = pack8(v0, v1); }
                } else if (mode == 2) {
                    const int pidx = row < 16384 ? (row & 2047) : 2048 + (row & 3);
                    const f32x4 c0 = *(const f32x4*)(cosT + pidx * 32 + 8 * fq), c1 = *(const f32x4*)(cosT + pidx * 32 + 8 * fq + 4), s0 = *(const f32x4*)(sinT + pidx * 32 + 8 * fq), s1 = *(const f32x4*)(sinT + pidx * 32 + 8 * fq + 4);
                    const f32x4 x10 = acc[ai][0][m][0] * r, x11 = acc[ai][0][m][1] * r, x20 = acc[ai][1][m][0] * r, x21 = acc[ai][1][m][1] * r;
                    bf16_t* o = dst + (size_t)row * 1024 + cb + wc * 64 + 8 * fq;
                    *(u32x4*)(o) = pack8(x10 * c0 - x20 * s0, x11 * c1 - x21 * s1); *(u32x4*)(o + 32) = pack8(x10 * s0 + x20 * c0, x11 * s1 + x21 * c1);
                } else {
#pragma unroll
                    for (int bj = 0; bj < 2; ++bj) { const int col = bj * HALF + wc * 32 + 8 * fq;
#pragma unroll
                        for (int n = 0; n < 2; ++n) { const f32x4 x = acc[ai][bj][m][n] * r + *(const f32x4*)(b_alpha + col + 4 * n); f32x4 y;
#pragma unroll
                            for (int e = 0; e < 4; ++e) y[e] = (fminf(x[e], 0.f) - __logf(1.0f + __expf(-fabsf(x[e])))) * 0.0625f;
                            *(f32x4*)(AL + (size_t)row * 256 + col + 4 * n) = y; } }
                }
            }
    }
};
struct EpiSig {
    static constexpr bool PERM = true, AFTER_DRAIN = false;
    bf16_t* S; const float* rp;
    __device__ __forceinline__ void operator()(const f32x4 (&acc)[2][2][4][2], const Unit& u, int wr, int wc, int fr, int fq) const {
        const int row0 = u.pm * BM + wr * 64 + fr, col0 = u.pn * BM + wc * 32 + 8 * fq;
#pragma unroll
        for (int ai = 0; ai < 2; ++ai)
#pragma unroll
            for (int m = 0; m < 4; ++m) { const int row = row0 + ai * HALF + m * 16; const float r = row_rs(rp, row);
#pragma unroll
                for (int bj = 0; bj < 2; ++bj) *(u32x4*)(S + (size_t)row * 1024 + col0 + bj * HALF) = pack8(sigm4(acc[ai][bj][m][0] * r), sigm4(acc[ai][bj][m][1] * r)); }
    }
};
struct EpiGateAcc {
    static constexpr bool PERM = true, AFTER_DRAIN = false;
    const bf16_t* S; float* H; bf16_t* XO; float* rp;
    __device__ __forceinline__ void operator()(const f32x4 (&acc)[2][2][4][2], const Unit& u, int wr, int wc, int fr, int fq) const {
        const int row0 = u.pm * BM + wr * 64 + fr, col0 = u.pn * BM + wc * 32 + 8 * fq;
#pragma unroll
        for (int ai = 0; ai < 2; ++ai)
#pragma unroll
            for (int m = 0; m < 4; ++m) { const int row = row0 + ai * HALF + m * 16; float ss = 0.f;
#pragma unroll
                for (int bj = 0; bj < 2; ++bj) { const size_t o = (size_t)row * 1024 + col0 + bj * HALF; f32x4 s0, s1; unpack8(*(const u32x4*)(S + o), s0, s1);
                    const f32x4 h0 = *(const f32x4*)(H + o) + s0 * acc[ai][bj][m][0], h1 = *(const f32x4*)(H + o + 4) + s1 * acc[ai][bj][m][1];
                    *(f32x4*)(H + o) = h0; *(f32x4*)(H + o + 4) = h1; if (XO) *(u32x4*)(XO + o) = pack8(h0, h1); ss += dot4(h0) + dot4(h1); }
                if (rp) { ss += __shfl_xor(ss, 16); ss += __shfl_xor(ss, 32); if (fq == 0) rp[((size_t)u.pn * 16896 + row) * 4 + wc] = ss; } }
    }
};

template <class Epi, class Sched, bool ALIGN_EPI = false, bool SP2 = false>
__device__ __forceinline__ void gemm_phase(PG8_LAS unsigned char* lds, const Gemm g, const Sched& S, const Epi& E) {
    const int tid = threadIdx.x, wid = __builtin_amdgcn_readfirstlane(tid >> 6), lane = tid & 63, wr = wid >> 2, wc = wid & 3, fr = lane & 15, fq = lane >> 4;
    const int K = g.K, nt = K / BK;
    unsigned voffA[2], voffB[2];
#pragma unroll
    for (int i = 0; i < 2; ++i) { int R, C; stage_rc(tid * 16 + i * 8192, R, C); const int Rb = Epi::PERM ? ((R & ~31) + perm32(R & 31)) : R;
        voffA[i] = (unsigned)(R * g.lda + C) * 2u; voffB[i] = (unsigned)(Rb * g.ldb + C) * 2u; }
    const size_t kstep = (size_t)(BK * 2);
    const size_t hstepA = (size_t)HALF * g.lda * 2, hstepB = (size_t)HALF * g.ldb * 2;
    const size_t tstepA = 2 * hstepA, tstepB = 2 * hstepB;
    const unsigned ldsw = (unsigned)wid * 1024u;
    const int aoff = lds_byte(wr * 64 + fr, fq * 8), boff = lds_byte(wc * 32 + fr, fq * 8);
#define PG8_SA(b, h) (((b) * 2 + (h)) * HTB)
#define PG8_SB(b, h) ((4 + (b) * 2 + (h)) * HTB)
#define PG8_STAGE(bufoff, gbase, voff) do { _Pragma("unroll") for (int _i = 0; _i < 2; ++_i) \
        __builtin_amdgcn_global_load_lds((const unsigned*)((const char*)(gbase) + (voff)[_i]), (PG8_LAS unsigned*)(lds + (bufoff) + ldsw + _i * 8192), 16, 0, 0); } while (0)
#define PG8_LDA(dst, b, h) do { _Pragma("unroll") for (int m = 0; m < 4; ++m) _Pragma("unroll") for (int k = 0; k < 2; ++k) dst[m][k] = *(const PG8_LAS bf16x8*)(lds + PG8_SA(b, h) + aoff + m * 2048 + k * 1024); } while (0)
#define PG8_LDB(dst, b, h) do { _Pragma("unroll") for (int n = 0; n < 2; ++n) _Pragma("unroll") for (int k = 0; k < 2; ++k) dst[n][k] = *(const PG8_LAS bf16x8*)(lds + PG8_SB(b, h) + boff + n * 2048 + k * 1024); } while (0)
#define PG8_MMA(ai, bj, At, Bt) do { __builtin_amdgcn_s_setprio(1); _Pragma("unroll") for (int m = 0; m < 4; ++m) _Pragma("unroll") for (int n = 0; n < 2; ++n) _Pragma("unroll") for (int k = 0; k < 2; ++k) \
        acc[ai][bj][m][n] = __builtin_amdgcn_mfma_f32_16x16x32_bf16(Bt[n][k], At[m][k], acc[ai][bj][m][n], 0, 0, 0); __builtin_amdgcn_s_setprio(0); } while (0)
#define PG8_WAIT_V(n) asm volatile("s_waitcnt vmcnt(" #n ")" ::: "memory")
#define PG8_WAIT_L(n) asm volatile("s_waitcnt lgkmcnt(" #n ")" ::: "memory")
#define PG8_BAR __builtin_amdgcn_s_barrier()
#define PG8_SCHED __builtin_amdgcn_sched_barrier(0)
    Unit cur, nxt; int ui = 0;
    if (!S.next(0, cur)) return;
    f32x4 acc[2][2][4][2];
#pragma unroll
    for (int a = 0; a < 2; ++a)
#pragma unroll
        for (int b = 0; b < 2; ++b)
#pragma unroll
            for (int m = 0; m < 4; ++m)
#pragma unroll
                for (int n = 0; n < 2; ++n) acc[a][b][m][n] = (f32x4){0.f, 0.f, 0.f, 0.f};
    bf16x8 At[4][2], B0[2][2], B1[2][2];
    const char* cA = (const char*)g.A + (size_t)cur.pm * tstepA; const char* cB = (const char*)g.Bt + (size_t)cur.pn * tstepB;
    S.a_ready(cur);
    if constexpr (SP2) {
        PG8_STAGE(PG8_SB(0, 0), cB, voffB); PG8_STAGE(PG8_SB(0, 1), cB + hstepB, voffB); PG8_STAGE(PG8_SA(0, 0), cA, voffA); PG8_STAGE(PG8_SA(0, 1), cA + hstepA, voffA);
        if (wr == 1) PG8_BAR;
        PG8_WAIT_V(2); PG8_BAR;
        PG8_STAGE(PG8_SB(1, 0), cB + kstep, voffB); PG8_STAGE(PG8_SA(1, 0), cA + kstep, voffA); PG8_STAGE(PG8_SB(1, 1), cB + hstepB + kstep, voffB);
        PG8_WAIT_V(6); PG8_BAR;
    } else {
        PG8_STAGE(PG8_SB(0, 0), cB, voffB); PG8_STAGE(PG8_SA(0, 0), cA, voffA); PG8_STAGE(PG8_SB(0, 1), cB + hstepB, voffB); PG8_STAGE(PG8_SA(0, 1), cA + hstepA, voffA);
        if (wr == 1) PG8_BAR;
        PG8_WAIT_V(4); PG8_BAR;
        PG8_STAGE(PG8_SB(1, 0), cB + kstep, voffB); PG8_STAGE(PG8_SA(1, 0), cA + kstep, voffA); PG8_STAGE(PG8_SB(1, 1), cB + hstepB + kstep, voffB);
        PG8_WAIT_V(6); PG8_BAR;
    }
    for (;;) {
        const bool has_next = S.next(ui + 1, nxt);
        const char* nA = has_next ? (const char*)g.A + (size_t)nxt.pm * tstepA : cA; const char* nB = has_next ? (const char*)g.Bt + (size_t)nxt.pn * tstepB : cB;
        for (int t = 0; t < nt; t += 2) {
            const bool last = (t == nt - 2);
            const char* a1 = cA + (size_t)(t + 1) * kstep;
            const char* a2 = last ? nA : cA + (size_t)(t + 2) * kstep; const char* b2 = last ? nB : cB + (size_t)(t + 2) * kstep;
            const char* a3 = a2 + kstep; const char* b3 = b2 + kstep;
            if (last && has_next) S.a_ready(nxt);
            if constexpr (SP2) {
            PG8_LDB(B0, 0, 0); PG8_LDB(B1, 0, 1); PG8_SCHED; PG8_LDA(At, 0, 0); PG8_STAGE(PG8_SA(1, 1), a1 + hstepA, voffA);
            PG8_WAIT_V(8); PG8_WAIT_L(0); PG8_BAR; PG8_MMA(0, 0, At, B0); PG8_MMA(0, 1, At, B1); PG8_BAR; PG8_SCHED;
            PG8_LDA(At, 0, 1); PG8_STAGE(PG8_SB(0, 0), b2, voffB); PG8_STAGE(PG8_SB(0, 1), b2 + hstepB, voffB); PG8_STAGE(PG8_SA(0, 0), a2, voffA);
            PG8_WAIT_V(8); PG8_WAIT_L(0); PG8_BAR; PG8_MMA(1, 0, At, B0); PG8_MMA(1, 1, At, B1); PG8_BAR; PG8_SCHED;
            PG8_LDB(B0, 1, 0); PG8_LDB(B1, 1, 1); PG8_SCHED; PG8_LDA(At, 1, 0); PG8_STAGE(PG8_SA(0, 1), a2 + hstepA, voffA);
            PG8_WAIT_V(8); PG8_WAIT_L(0); PG8_BAR; PG8_MMA(0, 0, At, B0); PG8_MMA(0, 1, At, B1); PG8_BAR; PG8_SCHED;
            PG8_LDA(At, 1, 1); PG8_STAGE(PG8_SB(1, 0), b3, voffB); PG8_STAGE(PG8_SB(1, 1), b3 + hstepB, voffB); PG8_STAGE(PG8_SA(1, 0), a3, voffA);
            PG8_WAIT_V(8); PG8_WAIT_L(0); PG8_BAR; PG8_MMA(1, 0, At, B0); PG8_MMA(1, 1, At, B1); PG8_BAR; PG8_SCHED;
            } else {
            PG8_LDB(B0, 0, 0); PG8_SCHED; PG8_LDA(At, 0, 0); PG8_STAGE(PG8_SA(1, 1), a1 + hstepA, voffA);
            PG8_WAIT_L(8); PG8_BAR; PG8_WAIT_L(0); PG8_MMA(0, 0, At, B0); PG8_BAR; PG8_SCHED;
            PG8_LDB(B1, 0, 1); PG8_STAGE(PG8_SB(0, 0), b2, voffB);
            PG8_BAR; PG8_WAIT_L(0); PG8_MMA(0, 1, At, B1); PG8_BAR;
            PG8_LDA(At, 0, 1); PG8_STAGE(PG8_SA(0, 0), a2, voffA);
            PG8_BAR; PG8_WAIT_L(0); PG8_MMA(1, 0, At, B0); PG8_BAR; PG8_SCHED;
            PG8_STAGE(PG8_SB(0, 1), b2 + hstepB, voffB);
            PG8_WAIT_V(6); PG8_BAR; PG8_MMA(1, 1, At, B1); PG8_BAR;
            PG8_LDB(B0, 1, 0); PG8_SCHED; PG8_LDA(At, 1, 0); PG8_STAGE(PG8_SA(0, 1), a2 + hstepA, voffA);
            PG8_WAIT_L(8); PG8_BAR; PG8_WAIT_L(0); PG8_MMA(0, 0, At, B0); PG8_BAR; PG8_SCHED;
            PG8_LDB(B1, 1, 1); PG8_STAGE(PG8_SB(1, 0), b3, voffB);
            PG8_BAR; PG8_WAIT_L(0); PG8_MMA(0, 1, At, B1); PG8_BAR;
            PG8_LDA(At, 1, 1); PG8_STAGE(PG8_SA(1, 0), a3, voffA);
            PG8_BAR; PG8_WAIT_L(0); PG8_MMA(1, 0, At, B0); PG8_BAR; PG8_SCHED;
            PG8_STAGE(PG8_SB(1, 1), b3 + hstepB, voffB);
            PG8_WAIT_V(6); PG8_BAR; PG8_MMA(1, 1, At, B1); PG8_BAR;
            }
        }
        if constexpr (ALIGN_EPI) { if (wr == 0) PG8_BAR; }
        if constexpr (!Epi::AFTER_DRAIN) { E(acc, cur, wr, wc, fr, fq); S.done(cur); }
        if (!has_next) break;
#pragma unroll
        for (int a = 0; a < 2; ++a)
#pragma unroll
            for (int b = 0; b < 2; ++b)
#pragma unroll
                for (int m = 0; m < 4; ++m)
#pragma unroll
                    for (int n = 0; n < 2; ++n) acc[a][b][m][n] = (f32x4){0.f, 0.f, 0.f, 0.f};
        cur = nxt; cA = nA; cB = nB; ++ui;
        if constexpr (ALIGN_EPI) { if (wr == 1) PG8_BAR; }
    }
    PG8_WAIT_V(0);
    if constexpr (!ALIGN_EPI) { if (wr == 0) PG8_BAR; }
    PG8_BAR;
    if constexpr (Epi::AFTER_DRAIN) { E.fused(acc, cur, wr, wc, fr, fq, lds, wid, lane); S.done(cur); }
#undef PG8_SA
#undef PG8_SB
#undef PG8_STAGE
#undef PG8_LDA
#undef PG8_LDB
#undef PG8_MMA
#undef PG8_WAIT_V
#undef PG8_WAIT_L
#undef PG8_BAR
#undef PG8_SCHED
}
}

constexpr int NWAVES = 8;
constexpr size_t MiB = 1u << 20, HMiB = 1u << 19;
constexpr size_t WS_W1T = 1 * MiB, WS_W1OT = 12 * MiB, WS_WQKVT = 17 * MiB + HMiB, WS_WGAT = 24 * MiB, WS_WGRT = 26 * MiB, WS_WOT = 28 * MiB, WS_W2T = 30 * MiB, WS_W2OT = 41 * MiB,
                 WS_WPGT = 46 * MiB + HMiB, WS_WPPT = 48 * MiB + HMiB;
constexpr size_t WS_XN = 49 * MiB, WS_XN2 = 82 * MiB, WS_QK = 115 * MiB, WS_V = 148 * MiB, WS_RG = 181 * MiB, WS_AL = 214 * MiB, WS_G = 115 * MiB;
constexpr size_t WS_RP1 = 230 * MiB + HMiB, WS_RP2 = WS_RP1 + MiB + MiB / 4, WS_RP3 = WS_RP2 + MiB + MiB / 4, WS_COS = WS_RP3 + MiB + MiB / 4, WS_SIN = WS_COS + HMiB, WS_PBF = WS_SIN + HMiB, WS_END = WS_PBF + 9 * MiB;
static_assert(WS_END <= 256 * MiB, "d_ws map");
static_assert(WS_G + (size_t)MT * FF * 2 <= WS_AL, "G overlays QK|V|RG only");
constexpr size_t OUT_YS = (size_t)MP * DM, OUT_GP = OUT_YS + (size_t)MS * DM, OUT_RP = OUT_GP + 262144, OUT_GS = OUT_RP + 262144, OUT_RS = OUT_GS + 4194304;
constexpr int LDS_BYTES = 147456, RING_BYTES = 131072;

#define LAS __attribute__((address_space(3)))
typedef unsigned short bf16;
typedef unsigned v4u __attribute__((ext_vector_type(4)));
typedef float f32x4 __attribute__((ext_vector_type(4)));
typedef short bf16x8 __attribute__((ext_vector_type(8)));
#define LDS_WAIT() asm volatile("s_waitcnt lgkmcnt(0)" ::: "memory")
__device__ __forceinline__ unsigned f2bf(float f) { unsigned u = __builtin_bit_cast(unsigned, f); return (u + 0x7fffu + ((u >> 16) & 1u)) >> 16; }
__device__ __forceinline__ unsigned pk2(float lo, float hi) { return f2bf(lo) | (f2bf(hi) << 16); }
__device__ __forceinline__ float bf2f(unsigned short v) { return __uint_as_float((unsigned)v << 16); }
__device__ __forceinline__ float wave_sum(float v) {
#pragma unroll
    for (int o = 1; o < 64; o <<= 1) v += __shfl_xor(v, o);
    return v;
}
static __device__ const float ROPE_FREQ[32] = {1.000000000e+00f, 7.498942614e-01f, 5.623413324e-01f, 4.216965139e-01f, 3.162277639e-01f, 2.371373773e-01f, 1.778279394e-01f, 1.333521307e-01f, 1.000000015e-01f, 7.498941571e-02f, 5.623413250e-02f, 4.216965288e-02f, 3.162277490e-02f, 2.371373773e-02f, 1.778279431e-02f, 1.333521493e-02f, 9.999999776e-03f, 7.498941850e-03f, 5.623413250e-03f, 4.216964822e-03f, 3.162277630e-03f, 2.371373586e-03f, 1.778279431e-03f, 1.333521446e-03f, 1.000000047e-03f, 7.498942432e-04f, 5.623413017e-04f, 4.216965172e-04f, 3.162277571e-04f, 2.371373703e-04f, 1.778279402e-04f, 1.333521504e-04f};
__device__ __forceinline__ float ret_lg(int h) { return h == 0 ? -0.0317486983145803f : h == 1 ? -0.015748356968139168f : h == 2 ? -0.007843177461025893f : -0.003913899321136329f; }

struct Args { const float* in[23]; float* out; unsigned char* ws; int ph_lo, ph_hi; };

__device__ __forceinline__ void p0_item(const float* W, int N, int k0, int n0, bf16* WT, int K, int drow0, const float* sc, LAS float* scr, int lane) {
#pragma unroll 8
    for (int i = 0; i < 32; ++i) { const int kk = 2 * i + (lane >> 5); float v = W[(size_t)(k0 + kk) * N + n0 + (lane & 31)]; if (sc) v *= sc[k0 + kk]; scr[kk * 33 + (lane & 31)] = v; }
    LDS_WAIT(); asm volatile("" ::: "memory");
    const int c = lane & 7;
#pragma unroll
    for (int j = 0; j < 4; ++j) { const int n = (lane >> 3) + 8 * j; const LAS float* s = scr + (8 * c) * 33 + n;
        v4u o; o.x = pk2(s[0 * 33], s[1 * 33]); o.y = pk2(s[2 * 33], s[3 * 33]); o.z = pk2(s[4 * 33], s[5 * 33]); o.w = pk2(s[6 * 33], s[7 * 33]);
        *(v4u*)(WT + (size_t)(drow0 + n) * K + k0 + 8 * c) = o; }
    LDS_WAIT(); asm volatile("" ::: "memory");
}
__device__ __forceinline__ void p0_ffn_in(const float* W, bf16* WT, const float* sc, int r, LAS float* scr, int lane) {
    const int kb = r / 176, nb = r % 176, n0 = nb * 32, which = n0 / 2816, hid = n0 % 2816;
    p0_item(W, 5632, kb * 64, n0, WT, 1024, (hid / 128) * 256 + which * 128 + (hid % 128), sc, scr, lane);
}
__device__ __forceinline__ void p0_plain(const float* W, int K, int N, bf16* WT, const float* sc, int r, LAS float* scr, int lane) {
    const int nblk = N / 32, kb = r / nblk, nb = r % nblk;
    p0_item(W, N, kb * 64, nb * 32, WT, K, nb * 32, sc, scr, lane);
}
__device__ __forceinline__ void prologue(const Args& a, LAS unsigned char* lds, int vcu, int G, int tid) {
    const int lane = tid & 63, wave = __builtin_amdgcn_readfirstlane(tid >> 6);
    unsigned char* ws = a.ws;
    LAS float* scr = (LAS float*)(lds + wave * 16384);
    const int gw = vcu * NWAVES + wave, NGW = G * NWAVES;
    const float* w_in = a.in[10];
    constexpr int I_A = 2816, I_B = 1408, I_C = 1536, I_D = 512, I_F = 512, I_J = 128;
    constexpr int NITEMS = 2 * I_A + 2 * I_B + I_C + 2 * I_D + 2 * I_F + I_J;
    for (int it = gw; it < NITEMS; it += NGW) {
        int r = it;
        if (r < I_A) { p0_ffn_in(a.in[7], (bf16*)(ws + WS_W1T), nullptr, r, scr, lane); continue; } r -= I_A;
        if (r < I_A) { p0_ffn_in(a.in[17], (bf16*)(ws + WS_W2T), a.in[16], r, scr, lane); continue; } r -= I_A;
        if (r < I_B) { p0_plain(a.in[8], 2816, 1024, (bf16*)(ws + WS_W1OT), nullptr, r, scr, lane); continue; } r -= I_B;
        if (r < I_B) { p0_plain(a.in[18], 2816, 1024, (bf16*)(ws + WS_W2OT), nullptr, r, scr, lane); continue; } r -= I_B;
        if (r < I_C) { const int kb = r / 96, nb = r % 96, n0 = nb * 32; int d0 = n0;
            if (n0 >= 1536 && n0 < 2048) { const int base = n0 < 1792 ? 1536 : 1792, loc = n0 - base; d0 = base + ((loc & 63) >> 5) * 128 + (loc >> 6) * 32; }
            p0_item(w_in, WIN_N, kb * 64, n0, (bf16*)(ws + WS_WQKVT), 1024, d0, a.in[9], scr, lane); continue; } r -= I_C;
        if (r < I_D) { const int kb = r / 32, nb = r % 32; p0_item(w_in, WIN_N, kb * 64, 3088 + nb * 32, (bf16*)(ws + WS_WGAT), 1024, nb * 32, a.in[9], scr, lane); continue; } r -= I_D;
        if (r < I_D) { const int kb = r / 32, nb = r % 32; p0_item(w_in, WIN_N, kb * 64, 4112 + nb * 32, (bf16*)(ws + WS_WGRT), 1024, nb * 32, a.in[9], scr, lane); continue; } r -= I_D;
        if (r < I_F) { p0_plain(a.in[15], 1024, 1024, (bf16*)(ws + WS_WOT), nullptr, r, scr, lane); continue; } r -= I_F;
        if (r < I_F) { p0_plain(a.in[20], 1024, 1024, (bf16*)(ws + WS_WPGT), a.in[19], r, scr, lane); continue; } r -= I_F;
        p0_plain(a.in[21], 256, 1024, (bf16*)(ws + WS_WPPT), nullptr, r, scr, lane);
    }
    const int gt = vcu * (NWAVES * 64) + tid, NGT = G * NWAVES * 64;
    { const float* wau = a.in[11]; const float* nm = a.in[9]; bf16* WT = (bf16*)(ws + WS_WQKVT);
      for (int task = gt; task < 256 * 128; task += NGT) { const int j = task >> 7, k8 = (task & 127) * 8; float wj[16];
#pragma unroll
          for (int r = 0; r < 16; ++r) wj[r] = wau[r * 256 + j];
          float o[8];
#pragma unroll
          for (int kk = 0; kk < 8; ++kk) { const f32x4* p = (const f32x4*)(w_in + (size_t)(k8 + kk) * WIN_N + 3072); float s = 0.f;
#pragma unroll
              for (int q = 0; q < 4; ++q) { const f32x4 x = p[q]; s += x[0] * wj[4 * q] + x[1] * wj[4 * q + 1] + x[2] * wj[4 * q + 2] + x[3] * wj[4 * q + 3]; }
              o[kk] = s * nm[k8 + kk]; }
          v4u w; w.x = pk2(o[0], o[1]); w.y = pk2(o[2], o[3]); w.z = pk2(o[4], o[5]); w.w = pk2(o[6], o[7]);
          *(v4u*)(WT + (size_t)(3072 + j) * 1024 + k8) = w; } }
    { const f32x4* nw = (const f32x4*)a.in[6] + lane; bf16* XN = (bf16*)(ws + WS_XN);
      for (int m = gw; m < MT; m += NGW) { const float* xrow = m < MP ? a.in[0] + (size_t)m * DM : a.in[1] + (size_t)(m - MP) * DM;
          const f32x4* xr = (const f32x4*)xrow + lane; f32x4 v[4]; float s = 0.f;
#pragma unroll
          for (int j = 0; j < 4; ++j) { v[j] = xr[64 * j]; s += pg8::dot4(v[j]); }
          const float rs = rsqrtf(wave_sum(s) * (1.f / DM) + 1e-6f);
          unsigned long long* o8 = (unsigned long long*)(XN + (size_t)m * DM) + lane;
#pragma unroll
          for (int j = 0; j < 4; ++j) { const f32x4 g = nw[64 * j]; o8[64 * j] = (unsigned long long)pk2(v[j][0] * rs * g[0], v[j][1] * rs * g[1]) | ((unsigned long long)pk2(v[j][2] * rs * g[2], v[j][3] * rs * g[3]) << 32); } } }
    { bf16* PB = (bf16*)(ws + WS_PBF);
      for (int task = gt; task < MT * DPLE / 8; task += NGT) { const size_t e = (size_t)task * 8; const float* src = e < (size_t)MP * DPLE ? a.in[4] + e : a.in[5] + (e - (size_t)MP * DPLE);
          const f32x4 x0 = *(const f32x4*)src, x1 = *(const f32x4*)(src + 4); v4u w; w.x = pk2(x0[0], x0[1]); w.y = pk2(x0[2], x0[3]); w.z = pk2(x1[0], x1[1]); w.w = pk2(x1[2], x1[3]);
          *(v4u*)(PB + e) = w; } }
    { float* cT = (float*)(ws + WS_COS); float* sT = (float*)(ws + WS_SIN);
      for (int task = gt; task < 2052 * 32; task += NGT) { const int pi = task >> 5, d = task & 31, pos = pi < 2048 ? pi : 16384 + (pi - 2048);
          const float ang = (float)pos * ROPE_FREQ[d]; double t = (double)ang * 0.15915494309189535; t -= __builtin_rint(t); const float tf = (float)t;
          cT[task] = __builtin_amdgcn_cosf(tf); sT[task] = __builtin_amdgcn_sinf(tf); } }
}

constexpr int LQ = 72, LO = 136;
constexpr int S_Q = 0, S_K = 9216, S_KT = 18432, S_VT = 27648, S_P = 46080, S_ST = 55296, S_O = 73728, S_TOT = 91136, S_LAM = 93184, S_PART = 93440;
#define MFMA16(a, b, c) __builtin_amdgcn_mfma_f32_16x16x32_bf16(a, b, c, 0, 0, 0)
__device__ __forceinline__ void scan_prompt(LAS unsigned char* lds, int item, const Args& a, int tid) {
    const int b = item >> 3, hb = item & 7, br = hb >> 2, h = hb & 3;
    const int lane = tid & 63, w = __builtin_amdgcn_readfirstlane(tid >> 6), fr = lane & 15, fq = lane >> 4;
    unsigned char* ws = a.ws;
    const bf16* QK = (const bf16*)(ws + WS_QK); const bf16* V = (const bf16*)(ws + WS_V); bf16* RG = (bf16*)(ws + WS_RG); const float* AL = (const float*)(ws + WS_AL);
    LAS bf16* sQ = (LAS bf16*)(lds + S_Q); LAS bf16* sK = (LAS bf16*)(lds + S_K); LAS bf16* sKT = (LAS bf16*)(lds + S_KT); LAS bf16* sVT = (LAS bf16*)(lds + S_VT);
    LAS bf16* sP = (LAS bf16*)(lds + S_P); LAS bf16* sST = (LAS bf16*)(lds + S_ST); LAS bf16* sO = (LAS bf16*)(lds + S_O);
    LAS float* sTOT = (LAS float*)(lds + S_TOT); LAS float* sLAM = (LAS float*)(lds + S_LAM); LAS float* sPART = (LAS float*)(lds + S_PART);
    const float lg = ret_lg(h);
    const int qoff = br * 512 + h * 64, koff = qoff + 256, voff = br * 512 + h * 128;
    const float gnw = (br ? a.in[14] : a.in[13])[h * 128 + w * 16 + fr];
    f32x4 accS[4];
#pragma unroll
    for (int i = 0; i < 4; ++i) accS[i] = (f32x4){0.f, 0.f, 0.f, 0.f};
    for (int i = tid; i < 128 * LQ / 2; i += 512) ((LAS unsigned*)(lds + S_ST))[i] = 0u;
    unsigned short pq[8], pk[8]; float pg[8]; v4u pv[2], pr[2];
#define SCAN_PREFETCH(ch) do { const size_t row0_ = (size_t)b * 2048 + (size_t)(ch) * 64; \
        _Pragma("unroll") for (int i = 0; i < 8; ++i) { const size_t row = row0_ + w * 8 + i; pq[i] = QK[row * 1024 + qoff + lane]; pk[i] = QK[row * 1024 + koff + lane]; pg[i] = br ? lg : AL[row * 256 + h * 64 + lane]; } \
        _Pragma("unroll") for (int j = 0; j < 2; ++j) { const int p = tid + j * 512, t = p >> 4, c8 = (p & 15) * 8; pv[j] = *(const v4u*)(V + (row0_ + t) * 1024 + voff + c8); pr[j] = *(const v4u*)(RG + (row0_ + t) * 1024 + voff + c8); } } while (0)
    SCAN_PREFETCH(0);
    for (int ch = 0; ch < 32; ++ch) {
        const size_t row0 = (size_t)b * 2048 + (size_t)ch * 64;
        float bl[8], qf[8], kf[8]; float run = 0.f;
#pragma unroll
        for (int i = 0; i < 8; ++i) { run += pg[i]; bl[i] = run; qf[i] = bf2f(pq[i]); kf[i] = bf2f(pk[i]); }
        sTOT[w * 64 + lane] = run;
        __syncthreads();
        float off = 0.f, tot = 0.f;
#pragma unroll
        for (int s = 0; s < 8; ++s) { const float x = sTOT[s * 64 + lane]; tot += x; if (s < w) off += x; }
#pragma unroll
        for (int i = 0; i < 8; ++i) { const int t = w * 8 + i; const float bb = off + bl[i];
            sQ[t * LQ + lane] = (bf16)f2bf(qf[i] * __expf(bb)); sK[t * LQ + lane] = (bf16)f2bf(kf[i] * __expf(-bb)); sKT[lane * LQ + t] = (bf16)f2bf(kf[i] * __expf(tot - bb)); }
        if (w == 0) sLAM[lane] = __expf(tot);
#pragma unroll
        for (int j = 0; j < 2; ++j) { const int p = tid + j * 512, t = p >> 4, c8 = (p & 15) * 8; const v4u x = pv[j];
            sVT[(c8 + 0) * LQ + t] = (bf16)(x.x & 0xffffu); sVT[(c8 + 1) * LQ + t] = (bf16)(x.x >> 16); sVT[(c8 + 2) * LQ + t] = (bf16)(x.y & 0xffffu); sVT[(c8 + 3) * LQ + t] = (bf16)(x.y >> 16);
            sVT[(c8 + 4) * LQ + t] = (bf16)(x.z & 0xffffu); sVT[(c8 + 5) * LQ + t] = (bf16)(x.z >> 16); sVT[(c8 + 6) * LQ + t] = (bf16)(x.w & 0xffffu); sVT[(c8 + 7) * LQ + t] = (bf16)(x.w >> 16); }
        v4u rr[2]; rr[0] = pr[0]; rr[1] = pr[1];
        if (ch + 1 < 32) SCAN_PREFETCH(ch + 1);
        __syncthreads();
        { const int it = w >> 1;
#pragma unroll
          for (int jj = 0; jj < 2; ++jj) { const int jt = (w & 1) * 2 + jj; f32x4 p = (f32x4){0.f, 0.f, 0.f, 0.f};
              if (jt <= it) {
#pragma unroll
                  for (int ks = 0; ks < 2; ++ks) { const bf16x8 x = *(const LAS bf16x8*)(sQ + (it * 16 + fr) * LQ + ks * 32 + fq * 8), y = *(const LAS bf16x8*)(sK + (jt * 16 + fr) * LQ + ks * 32 + fq * 8); p = MFMA16(x, y, p); } }
#pragma unroll
              for (int r = 0; r < 4; ++r) { const int gi = it * 16 + 4 * fq + r, gj = jt * 16 + fr; sP[gi * LQ + gj] = (bf16)f2bf(gj <= gi ? p[r] : 0.f); } } }
#pragma unroll
        for (int dt = 0; dt < 4; ++dt) { const float lam = sLAM[dt * 16 + fr]; accS[dt] = accS[dt] * lam;
#pragma unroll
            for (int ks = 0; ks < 2; ++ks) { const bf16x8 x = *(const LAS bf16x8*)(sVT + (w * 16 + fr) * LQ + ks * 32 + fq * 8), y = *(const LAS bf16x8*)(sKT + (dt * 16 + fr) * LQ + ks * 32 + fq * 8); accS[dt] = MFMA16(x, y, accS[dt]); } }
        __syncthreads();
        f32x4 accO[4];
        { bf16x8 bv[2], bs[2];
#pragma unroll
          for (int ks = 0; ks < 2; ++ks) { bv[ks] = *(const LAS bf16x8*)(sVT + (w * 16 + fr) * LQ + ks * 32 + fq * 8); bs[ks] = *(const LAS bf16x8*)(sST + (w * 16 + fr) * LQ + ks * 32 + fq * 8); }
#pragma unroll
          for (int it = 0; it < 4; ++it) { f32x4 o = (f32x4){0.f, 0.f, 0.f, 0.f};
#pragma unroll
              for (int ks = 0; ks < 2; ++ks) { const bf16x8 x = *(const LAS bf16x8*)(sP + (it * 16 + fr) * LQ + ks * 32 + fq * 8); o = MFMA16(x, bv[ks], o); }
#pragma unroll
              for (int ks = 0; ks < 2; ++ks) { const bf16x8 x = *(const LAS bf16x8*)(sQ + (it * 16 + fr) * LQ + ks * 32 + fq * 8); o = MFMA16(x, bs[ks], o); }
              accO[it] = o;
#pragma unroll
              for (int r = 0; r < 4; ++r) { float s = o[r] * o[r]; s += __shfl_xor(s, 1); s += __shfl_xor(s, 2); s += __shfl_xor(s, 4); s += __shfl_xor(s, 8); if (fr == 0) sPART[(it * 16 + 4 * fq + r) * 8 + w] = s; } } }
        __syncthreads();
#pragma unroll
        for (int it = 0; it < 4; ++it)
#pragma unroll
            for (int r = 0; r < 4; ++r) { const int i = it * 16 + 4 * fq + r; const f32x4 p0 = *(const LAS f32x4*)(sPART + i * 8), p1 = *(const LAS f32x4*)(sPART + i * 8 + 4);
                const float ss = ((p0[0] + p0[1]) + (p0[2] + p0[3])) + ((p1[0] + p1[1]) + (p1[2] + p1[3])); const float rs = rsqrtf(ss * (1.0f / 128.0f) + 1e-6f);
                sO[i * LO + w * 16 + fr] = (bf16)f2bf(accO[it][r] * rs * gnw); }
#pragma unroll
        for (int dt = 0; dt < 4; ++dt)
#pragma unroll
            for (int r = 0; r < 4; ++r) sST[(w * 16 + 4 * fq + r) * LQ + dt * 16 + fr] = (bf16)f2bf(accS[dt][r]);
        __syncthreads();
#pragma unroll
        for (int j = 0; j < 2; ++j) { const int p = tid + j * 512, i = p >> 4, c8 = (p & 15) * 8; const v4u o8 = *(const LAS v4u*)(sO + i * LO + c8); const v4u g8 = rr[j]; v4u w8;
            w8.x = pk2(__uint_as_float(o8.x << 16) * __uint_as_float(g8.x << 16), __uint_as_float(o8.x & 0xffff0000u) * __uint_as_float(g8.x & 0xffff0000u));
            w8.y = pk2(__uint_as_float(o8.y << 16) * __uint_as_float(g8.y << 16), __uint_as_float(o8.y & 0xffff0000u) * __uint_as_float(g8.y & 0xffff0000u));
            w8.z = pk2(__uint_as_float(o8.z << 16) * __uint_as_float(g8.z << 16), __uint_as_float(o8.z & 0xffff0000u) * __uint_as_float(g8.z & 0xffff0000u));
            w8.w = pk2(__uint_as_float(o8.w << 16) * __uint_as_float(g8.w << 16), __uint_as_float(o8.w & 0xffff0000u) * __uint_as_float(g8.w & 0xffff0000u));
            *(v4u*)(RG + (row0 + i) * 1024 + voff + c8) = w8; }
    }
#undef SCAN_PREFETCH
    float* so = a.out + (br ? OUT_RP : OUT_GP) + (size_t)(b * 4 + h) * 8192;
#pragma unroll
    for (int dt = 0; dt < 4; ++dt)
#pragma unroll
        for (int r = 0; r < 4; ++r) so[(dt * 16 + fr) * 128 + w * 16 + 4 * fq + r] = accS[dt][r];
    __syncthreads();
}
__device__ __forceinline__ void scan_sample(LAS unsigned char* lds, int item, const Args& a, int tid) {
    const int bs = item >> 3, hb = item & 7, br = hb >> 2, h = hb & 3;
    const int lane = tid & 63, w = __builtin_amdgcn_readfirstlane(tid >> 6);
    unsigned char* ws = a.ws;
    const bf16* QK = (const bf16*)(ws + WS_QK); const bf16* Vb = (const bf16*)(ws + WS_V); bf16* RG = (bf16*)(ws + WS_RG); const float* AL = (const float*)(ws + WS_AL);
    LAS float* L = (LAS float*)lds;
    LAS float* sQ = L; LAS float* sK = L + 256; LAS float* sG = L + 512; LAS float* sV = L + 768; LAS float* sGT = L + 1280; LAS float* sQT = L + 1792; LAS float* sKH = L + 2048;
    LAS float* sLAM = L + 2304; LAS float* sPP = L + 2368; LAS float* sOP = L + 2384; LAS float* sSS = L + 4432;
    const size_t row0 = (size_t)MP + (size_t)bs * 4;
    const int qoff = br * 512 + h * 64, koff = qoff + 256, voff = br * 512 + h * 128;
    const float* S0 = (br ? a.in[3] : a.in[2]) + (size_t)(bs * 4 + h) * 8192;
    float* S1 = a.out + (br ? OUT_RS : OUT_GS) + (size_t)(bs * 4 + h) * 8192;
    const float* gn = (br ? a.in[14] : a.in[13]) + h * 128;
    const int c = tid & 127, dq = tid >> 7;
    float s0[16];
#pragma unroll
    for (int dd = 0; dd < 16; ++dd) s0[dd] = S0[(dq * 16 + dd) * 128 + c];
    if (tid < 256) { const int t = tid >> 6, d = tid & 63; const size_t row = row0 + t; sQ[t * 64 + d] = bf2f(QK[row * 1024 + qoff + d]); sK[t * 64 + d] = bf2f(QK[row * 1024 + koff + d]); sG[t * 64 + d] = br ? ret_lg(h) : AL[row * 256 + h * 64 + d]; }
    { const int t = tid >> 7; sV[t * 128 + c] = bf2f(Vb[(row0 + t) * 1024 + voff + c]); sGT[t * 128 + c] = bf2f(RG[(row0 + t) * 1024 + voff + c]); }
    const float gnc = gn[c];
    __syncthreads();
    if (tid < 64) { const int d = tid; float bc[4]; float run = 0.f;
#pragma unroll
        for (int t = 0; t < 4; ++t) { run += sG[t * 64 + d]; bc[t] = run; }
#pragma unroll
        for (int t = 0; t < 4; ++t) { sQT[t * 64 + d] = sQ[t * 64 + d] * __expf(bc[t]); sKH[t * 64 + d] = sK[t * 64 + d] * __expf(bc[3] - bc[t]); }
        sLAM[d] = __expf(bc[3]);
#pragma unroll
        for (int t = 0; t < 4; ++t)
#pragma unroll
            for (int j = 0; j < 4; ++j) if (j <= t) { float p = sQ[t * 64 + d] * sK[j * 64 + d] * __expf(bc[t] - bc[j]); p = wave_sum(p); if (d == 0) sPP[t * 4 + j] = p; } }
    __syncthreads();
    { float po[4] = {0.f, 0.f, 0.f, 0.f}; float vj[4];
#pragma unroll
      for (int j = 0; j < 4; ++j) vj[j] = sV[j * 128 + c];
#pragma unroll
      for (int dd = 0; dd < 16; ++dd) { const int d = dq * 16 + dd; const float s = s0[dd];
#pragma unroll
          for (int t = 0; t < 4; ++t) po[t] += sQT[t * 64 + d] * s;
          float sn = sLAM[d] * s;
#pragma unroll
          for (int j = 0; j < 4; ++j) sn += sKH[j * 64 + d] * vj[j];
          S1[d * 128 + c] = sn; }
#pragma unroll
      for (int t = 0; t < 4; ++t) sOP[(dq * 4 + t) * 128 + c] = po[t]; }
    __syncthreads();
    { const int t = tid >> 7; float o = (sOP[(0 * 4 + t) * 128 + c] + sOP[(1 * 4 + t) * 128 + c]) + (sOP[(2 * 4 + t) * 128 + c] + sOP[(3 * 4 + t) * 128 + c]);
#pragma unroll
      for (int j = 0; j < 4; ++j) if (j <= t) o += sPP[t * 4 + j] * sV[j * 128 + c];
      const float ss = wave_sum(o * o); if (lane == 0) sSS[w] = ss;
      __syncthreads();
      const float rs = rsqrtf((sSS[2 * t] + sSS[2 * t + 1]) * (1.0f / 128.0f) + 1e-6f);
      RG[(row0 + t) * 1024 + voff + c] = (bf16)f2bf(o * rs * gnc * sGT[t * 128 + c]); }
    __syncthreads();
}

__global__ void __launch_bounds__(NWAVES * 64, 2) mk_fwd(Args args) {
    extern __shared__ __attribute__((aligned(16))) unsigned char lds_raw[];
    LAS unsigned char* lds = (LAS unsigned char*)lds_raw;
    const int tid = threadIdx.x, lane = tid & 63, wave = __builtin_amdgcn_readfirstlane(tid >> 6);
    const int G = gridDim.x, bx = blockIdx.x, vcu = (G % 8 == 0) ? (bx % 8) * (G / 8) + bx / 8 : bx;
    unsigned char* ws = args.ws;
    const int lo = args.ph_lo, hi = args.ph_hi;
#define IN(k) (lo <= (k) && (k) < hi)
#if MK_SINGLE
#define SEAM(k) do { if (IN(k) && IN((k) + 1)) cg::this_grid().sync(); } while (0)
#else
#define SEAM(k) do { } while (0)
#endif
    bf16* XN = (bf16*)(ws + WS_XN); bf16* XN2 = (bf16*)(ws + WS_XN2); bf16* GB = (bf16*)(ws + WS_G);
    bf16* QK = (bf16*)(ws + WS_QK); bf16* VB = (bf16*)(ws + WS_V); bf16* RG = (bf16*)(ws + WS_RG); float* AL = (float*)(ws + WS_AL);
    float* RP1 = (float*)(ws + WS_RP1); float* RP2 = (float*)(ws + WS_RP2); float* RP3 = (float*)(ws + WS_RP3);
    float* H = args.out;

    if (IN(0)) { prologue(args, lds, vcu, G, tid); } SEAM(0);
    if (IN(1)) {
        pg8::Gemm g{XN, (const bf16*)(ws + WS_W1T), MT, 2 * FF, DM, DM, DM}; pg8::StaticOrder S; S.init(MT, 2 * FF, G, bx);
        pg8::EpiSwiGLU E{GB, nullptr};
        pg8::gemm_phase<pg8::EpiSwiGLU, pg8::StaticOrder, true, true>(lds, g, S, E);
    } SEAM(1);
    if (IN(2)) {
        pg8::Gemm g{GB, (const bf16*)(ws + WS_W1OT), MT, DM, FF, FF, FF}; pg8::StaticOrder S; S.init(MT, DM, G, bx);
        pg8::EpiResid E{args.in[0], args.in[1], H, XN, RP1};
        pg8::gemm_phase<pg8::EpiResid, pg8::StaticOrder, true, true>(lds, g, S, E);
    } SEAM(2);
    if (IN(3)) {
        pg8::Gemm g{XN, (const bf16*)(ws + WS_WQKVT), MT, NQKV, DM, DM, DM}; pg8::StaticOrder S; S.init(MT, NQKV, G, bx);
        pg8::EpiQKV E{QK, VB, RG, AL, RP1, args.in[12], (const float*)(ws + WS_COS), (const float*)(ws + WS_SIN)};
        pg8::gemm_phase<pg8::EpiQKV, pg8::StaticOrder, true, true>(lds, g, S, E);
    } SEAM(3);
    if (IN(4)) {
        if (G >= 128) { if (bx < 64) scan_prompt(lds, bx, args, tid); else for (int it = bx - 64; it < 1024; it += G - 64) scan_sample(lds, it, args, tid); }
        else { for (int it = bx; it < 64; it += G) scan_prompt(lds, it, args, tid); for (int it = bx; it < 1024; it += G) scan_sample(lds, it, args, tid); }
    } SEAM(4);
    if (IN(5)) {
        pg8::StaticOrder S; S.init(MT, DM, G, bx);
        { pg8::Gemm g{XN, (const bf16*)(ws + WS_WGAT), MT, DM, DM, DM, DM}; pg8::EpiSig E{QK, RP1}; pg8::gemm_phase<pg8::EpiSig, pg8::StaticOrder, true, true>(lds, g, S, E); }
        { pg8::Gemm g{XN, (const bf16*)(ws + WS_WGRT), MT, DM, DM, DM, DM}; pg8::EpiSig E{VB, RP1}; pg8::gemm_phase<pg8::EpiSig, pg8::StaticOrder, true, true>(lds, g, S, E); }
        { pg8::Gemm g{RG, (const bf16*)(ws + WS_WOT), MT, DM, 512, DM, DM}; pg8::EpiGateAcc E{QK, H, nullptr, nullptr}; pg8::gemm_phase<pg8::EpiGateAcc, pg8::StaticOrder, true, true>(lds, g, S, E); }
        { pg8::Gemm g{RG + 512, (const bf16*)(ws + WS_WOT) + 512, MT, DM, 512, DM, DM}; pg8::EpiGateAcc E{VB, H, XN2, RP2}; pg8::gemm_phase<pg8::EpiGateAcc, pg8::StaticOrder, true, true>(lds, g, S, E); }
    } SEAM(5);
    if (IN(6)) {
        pg8::Gemm g{XN2, (const bf16*)(ws + WS_W2T), MT, 2 * FF, DM, DM, DM}; pg8::StaticOrder S; S.init(MT, 2 * FF, G, bx);
        pg8::EpiSwiGLU E{GB, RP2};
        pg8::gemm_phase<pg8::EpiSwiGLU, pg8::StaticOrder, true, true>(lds, g, S, E);
    } SEAM(6);
    if (IN(7)) {
        pg8::Gemm g{GB, (const bf16*)(ws + WS_W2OT), MT, DM, FF, FF, FF}; pg8::StaticOrder S; S.init(MT, DM, G, bx);
        pg8::EpiResid E{H, H + (size_t)MP * DM, H, XN, RP3};
        pg8::gemm_phase<pg8::EpiResid, pg8::StaticOrder, true, true>(lds, g, S, E);
    } SEAM(7);
    if (IN(8)) {
        pg8::StaticOrder S; S.init(MT, DM, G, bx);
        { pg8::Gemm g{XN, (const bf16*)(ws + WS_WPGT), MT, DM, DM, DM, DM}; pg8::EpiSig E{QK, RP3}; pg8::gemm_phase<pg8::EpiSig, pg8::StaticOrder, true, true>(lds, g, S, E); }
        { pg8::Gemm g{(const bf16*)(ws + WS_PBF), (const bf16*)(ws + WS_WPPT), MT, DM, DPLE, DPLE, DPLE}; pg8::EpiGateAcc E{QK, H, nullptr, nullptr}; pg8::gemm_phase<pg8::EpiGateAcc, pg8::StaticOrder, true, true>(lds, g, S, E); }
    } SEAM(8);
    if (IN(9)) {
        const f32x4* nw = (const f32x4*)args.in[22] + lane; const int gw = vcu * NWAVES + wave, NGW = G * NWAVES;
        for (int m = gw; m < MT; m += NGW) { f32x4* xr = (f32x4*)(H + (size_t)m * DM) + lane; f32x4 v[4]; float s = 0.f;
#pragma unroll
            for (int j = 0; j < 4; ++j) { v[j] = xr[64 * j]; s += pg8::dot4(v[j]); }
            const float rs = rsqrtf(wave_sum(s) * (1.f / DM) + 1e-6f);
#pragma unroll
            for (int j = 0; j < 4; ++j) xr[64 * j] = v[j] * rs * nw[64 * j]; }
    }
#undef IN
#undef SEAM
}

extern "C" void kernel_launch(void* const* d_in, const int* in_sizes, int n_in, void* d_out, int out_size, void* d_ws, size_t ws_size, hipStream_t stream) {
    static int grid = 0;
    if (grid == 0) {
        if (n_in != 23 || ws_size < WS_END) { fprintf(stderr, "kernel_launch: unexpected inputs (n_in %d, ws %zu)\n", n_in, ws_size); grid = -1; return; }
        int dev = 0, cus = 0, per_cu = 0;
        if (hipGetDevice(&dev) != hipSuccess || hipDeviceGetAttribute(&cus, hipDeviceAttributeMultiprocessorCount, dev) != hipSuccess) { grid = -1; return; }
        if (hipFuncSetAttribute((const void*)mk_fwd, hipFuncAttributeMaxDynamicSharedMemorySize, LDS_BYTES) != hipSuccess) { fprintf(stderr, "kernel_launch: hipFuncSetAttribute failed\n"); grid = -1; return; }
        if (hipOccupancyMaxActiveBlocksPerMultiprocessor(&per_cu, (const void*)mk_fwd, NWAVES * 64, LDS_BYTES) != hipSuccess || per_cu < 1) { per_cu = 1; (void)hipGetLastError(); }
        grid = cus * 1;
    }
    if (grid < 0) return;
    Args a{};
    for (int i = 0; i < 23; ++i) a.in[i] = (const float*)d_in[i];
    a.out = (float*)d_out; a.ws = (unsigned char*)d_ws;
#if MK_SINGLE
    a.ph_lo = 0; a.ph_hi = 10;
    void* kargs[] = {&a};
    hipError_t e = hipLaunchCooperativeKernel((const void*)mk_fwd, dim3(grid), dim3(NWAVES * 64), kargs, LDS_BYTES, stream);
    if (e != hipSuccess) fprintf(stderr, "kernel_launch: cooperative launch failed: %s (grid %d)\n", hipGetErrorString(e), grid);
#else
    for (int p = 0; p < 10; ++p) { a.ph_lo = p; a.ph_hi = p + 1; hipLaunchKernelGGL(mk_fwd, dim3(grid), dim3(NWAVES * 64), LDS_BYTES, stream, a); }
#endif
}
```

```cpp
#include <hip/hip_runtime.h>
#include <hip/hip_cooperative_groups.h>
#include <cstdio>
#include <cstdint>
namespace cg = cooperative_groups;
#ifndef MK_SINGLE
#define MK_SINGLE 1
#endif
constexpr int MP = 16384, MS = 512, MT = MP + MS, DM = 1024, FF = 2816, NQKV = 3328, DPLE = 256, WIN_N = 5136;
namespace pg8 {
#define PG8_LAS __attribute__((address_space(3)))
typedef unsigned short bf16_t;
typedef short bf16x8 __attribute__((ext_vector_type(8)));
typedef float f32x4 __attribute__((ext_vector_type(4)));
typedef unsigned u32x4 __attribute__((ext_vector_type(4)));
constexpr int BM = 256, BK = 64, HALF = 128, HTB = HALF * BK * 2  , STAGE_BYTES = 8 * HTB, NXCD = 8, WGM = 8;

__host__ __device__ __forceinline__ int lds_byte(int r, int c) { const int st = (r >> 4) * 2 + (c >> 5), rr = r & 15, cc = c & 31, ob = rr * 64 + cc * 2; return st * 1024 + (ob ^ (((ob >> 9) & 1) << 5)); }
__host__ __device__ __forceinline__ void stage_rc(int b, int& R, int& C) { const int st = b / 1024, sb = b % 1024, swz = sb ^ (((sb >> 9) & 1) << 5); R = (st >> 1) * 16 + swz / 64; C = (st & 1) * 32 + (swz % 64) / 2; }
__host__ __device__ __forceinline__ int perm32(int rho) { const int n = rho >> 4, i = rho & 15; return 8 * (i >> 2) + 4 * n + (i & 3); }

struct Unit { int pm, pn; };
struct Gemm { const bf16_t* A; const bf16_t* Bt; int M, N, K, lda, ldb; };

struct StaticOrder {
    int nM, nN, nwg, G, c;
    __host__ __device__ void init(int M, int N, int G_, int c_) { nM = M / BM; nN = N / BM; nwg = nM * nN; G = G_; c = c_; }
    __host__ __device__ bool next(int i, Unit& u) const {
        const long L = (long)i * G + c; if (L >= nwg) return false;
        int wgid = (int)L; { const int q = nwg / NXCD, r = nwg % NXCD, xcd = wgid % NXCD, off = wgid / NXCD; wgid = (xcd < r ? xcd * (q + 1) : r * (q + 1) + (xcd - r) * q) + off; }
        const int nig = WGM * nN, gid = wgid / nig, fm = gid * WGM, gsz = (nM - fm) < WGM ? (nM - fm) : WGM;
        u.pm = fm + ((wgid % nig) % gsz); u.pn = (wgid % nig) / gsz; return true;
    }
    __device__ __forceinline__ void a_ready(const Unit&) const {}
    __device__ __forceinline__ void done(const Unit&) const {}
};


__device__ __forceinline__ unsigned cvt_pk_bf16(float lo, float hi) { unsigned r; asm volatile("v_cvt_pk_bf16_f32 %0, %1, %2" : "=v"(r) : "v"(lo), "v"(hi)); return r; }
__device__ __forceinline__ u32x4 pack8(const f32x4 a, const f32x4 b) { u32x4 w; w.x = cvt_pk_bf16(a[0], a[1]); w.y = cvt_pk_bf16(a[2], a[3]); w.z = cvt_pk_bf16(b[0], b[1]); w.w = cvt_pk_bf16(b[2], b[3]); return w; }
__device__ __forceinline__ void unpack8(const u32x4 w, f32x4& a, f32x4& b) {
    a[0] = __uint_as_float(w.x << 16); a[1] = __uint_as_float(w.x & 0xffff0000u); a[2] = __uint_as_float(w.y << 16); a[3] = __uint_as_float(w.y & 0xffff0000u);
    b[0] = __uint_as_float(w.z << 16); b[1] = __uint_as_float(w.z & 0xffff0000u); b[2] = __uint_as_float(w.w << 16); b[3] = __uint_as_float(w.w & 0xffff0000u); }
__device__ __forceinline__ float sigm(float x) { return __builtin_amdgcn_rcpf(1.0f + __builtin_amdgcn_exp2f(-1.4426950408889634f * x)); }
__device__ __forceinline__ f32x4 sigm4(const f32x4 x) { f32x4 r; r[0] = sigm(x[0]); r[1] = sigm(x[1]); r[2] = sigm(x[2]); r[3] = sigm(x[3]); return r; }
__device__ __forceinline__ f32x4 silu4(const f32x4 x) { return x * sigm4(x); }
__device__ __forceinline__ float dot4(const f32x4 a) { return (a[0] * a[0] + a[1] * a[1]) + (a[2] * a[2] + a[3] * a[3]); }
__device__ __forceinline__ float row_rs(const float* rp, int row) {
    const f32x4 a = *(const f32x4*)(rp + ((size_t)0 * 16896 + row) * 4), b = *(const f32x4*)(rp + ((size_t)1 * 16896 + row) * 4), c = *(const f32x4*)(rp + ((size_t)2 * 16896 + row) * 4), d = *(const f32x4*)(rp + ((size_t)3 * 16896 + row) * 4);
    const float s = (((a[0] + a[1]) + (a[2] + a[3])) + ((b[0] + b[1]) + (b[2] + b[3]))) + (((c[0] + c[1]) + (c[2] + c[3])) + ((d[0] + d[1]) + (d[2] + d[3])));
    return rsqrtf(s * (1.0f / 1024.0f) + 1e-6f);
}

struct EpiSwiGLU {
    static constexpr bool PERM = true, AFTER_DRAIN = false;
    bf16_t* G; const float* rp;
    __device__ __forceinline__ void operator()(const f32x4 (&acc)[2][2][4][2], const Unit& u, int wr, int wc, int fr, int fq) const {
        const int row0 = u.pm * BM + wr * 64 + fr, col0 = u.pn * 128 + wc * 32 + 8 * fq;
#pragma unroll
        for (int ai = 0; ai < 2; ++ai)
#pragma unroll
            for (int m = 0; m < 4; ++m) { const int row = row0 + ai * HALF + m * 16; const float r = rp ? row_rs(rp, row) : 1.0f;
                const f32x4 g0 = silu4(acc[ai][0][m][0] * r) * (acc[ai][1][m][0] * r), g1 = silu4(acc[ai][0][m][1] * r) * (acc[ai][1][m][1] * r);
                *(u32x4*)(G + (size_t)row * 2816 + col0) = pack8(g0, g1); }
    }
};
struct EpiResid {
    static constexpr bool PERM = true, AFTER_DRAIN = false;
    const float* baseP; const float* baseS; float* H; bf16_t* XO; float* rp;
    __device__ __forceinline__ void operator()(const f32x4 (&acc)[2][2][4][2], const Unit& u, int wr, int wc, int fr, int fq) const {
        const int row0 = u.pm * BM + wr * 64 + fr, col0 = u.pn * BM + wc * 32 + 8 * fq;
#pragma unroll
        for (int ai = 0; ai < 2; ++ai)
#pragma unroll
            for (int m = 0; m < 4; ++m) { const int row = row0 + ai * HALF + m * 16;
                const float* bp = (row < 16384 ? baseP + (size_t)row * 1024 : baseS + (size_t)(row - 16384) * 1024) + col0; float ss = 0.f;
#pragma unroll
                for (int bj = 0; bj < 2; ++bj) { const f32x4 x0 = *(const f32x4*)(bp + bj * HALF), x1 = *(const f32x4*)(bp + bj * HALF + 4);
                    const f32x4 h0 = x0 + acc[ai][bj][m][0] * 0.5f, h1 = x1 + acc[ai][bj][m][1] * 0.5f; const size_t o = (size_t)row * 1024 + col0 + bj * HALF;
                    *(f32x4*)(H + o) = h0; *(f32x4*)(H + o + 4) = h1; *(u32x4*)(XO + o) = pack8(h0, h1); ss += dot4(h0) + dot4(h1); }
                ss += __shfl_xor(ss, 16); ss += __shfl_xor(ss, 32);
                if (fq == 0) rp[((size_t)u.pn * 16896 + row) * 4 + wc] = ss; }
    }
};
struct EpiQKV {
    static constexpr bool PERM = true, AFTER_DRAIN = false;
    bf16_t *QK, *V, *RG; float* AL; const float* rp; const float* b_alpha; const float* cosT; const float* sinT;
    __device__ __forceinline__ void operator()(const f32x4 (&acc)[2][2][4][2], const Unit& u, int wr, int wc, int fr, int fq) const {
        const int pn = u.pn; int mode = 0, cb = 0; bf16_t* dst = QK; float sc = 1.0f;
        if (pn == 0) { sc = 0.125f; } else if (pn == 1) { cb = 256; } else if (pn <= 3) { dst = V; cb = (pn - 2) * 256; } else if (pn <= 5) { mode = 1; dst = RG; cb = (pn - 4) * 256; }
        else if (pn == 6) { mode = 2; cb = 512; } else if (pn == 7) { mode = 2; cb = 768; sc = 0.125f; } else if (pn <= 9) { dst = V; cb = 512 + (pn - 8) * 256; }
        else if (pn <= 11) { mode = 1; dst = RG; cb = 512 + (pn - 10) * 256; } else { mode = 3; }
        const int row0 = u.pm * BM + wr * 64 + fr;
#pragma unroll
        for (int ai = 0; ai < 2; ++ai)
#pragma unroll
            for (int m = 0; m < 4; ++m) { const int row = row0 + ai * HALF + m * 16; const float r = row_rs(rp, row) * sc;
                if (mode <= 1) {
#pragma unroll
                    for (int bj = 0; bj < 2; ++bj) { f32x4 v0 = acc[ai][bj][m][0] * r, v1 = acc[ai][bj][m][1] * r; if (mode == 1) { v0 = silu4(v0); v1 = silu4(v1); }
                        *(u32x4*)(dst + (size_t)row * 1024 + cb + bj * HALF + wc * 32 + 8 * fq) = pack8(v0, v1); }
                } else if (mode == 2) {
                    const int pidx = row < 16384 ? (row & 2047) : 2048 + (row & 3);
                    const f32x4 c0 = *(const f32x4*)(cosT + pidx * 32 + 8 * fq), c1 = *(const f32x4*)(cosT + pidx * 32 + 8 * fq + 4), s0 = *(const f32x4*)(sinT + pidx * 32 + 8 * fq), s1 = *(const f32x4*)(sinT + pidx * 32 + 8 * fq + 4);
                    const f32x4 x10 = acc[ai][0][m][0] * r, x11 = acc[ai][0][m][1] * r, x20 = acc[ai][1][m][0] * r, x21 = acc[ai][1][m][1] * r;
                    bf16_t* o = dst + (size_t)row * 1024 + cb + wc * 64 + 8 * fq;
                    *(u32x4*)(o) = pack8(x10 * c0 - x20 * s0, x11 * c1 - x21 * s1); *(u32x4*)(o + 32) = pack8(x10 * s0 + x20 * c0, x11 * s1 + x21 * c1);
                } else {
#pragma unroll
                    for (int bj = 0; bj < 2; ++bj) { const int col = bj * HALF + wc * 32 + 8 * fq;
#pragma unroll
                        for (int n = 0; n < 2; ++n) { const f32x4 x = acc[ai][bj][m][n] * r + *(const f32x4*)(b_alpha + col + 4 * n); f32x4 y;
#pragma unroll
                            for (int e = 0; e < 4; ++e) y[e] = (fminf(x[e], 0.f) - __logf(1.0f + __expf(-fabsf(x[e])))) * 0.0625f;
                            *(f32x4*)(AL + (size_t)row * 256 + col + 4 * n) = y; } }
                }
            }
    }
};
struct EpiSig {
    static constexpr bool PERM = true, AFTER_DRAIN = false;
    bf16_t* S; const float* rp;
    __device__ __forceinline__ void operator()(const f32x4 (&acc)[2][2][4][2], const Unit& u, int wr, int wc, int fr, int fq) const {
        const int row0 = u.pm * BM + wr * 64 + fr, col0 = u.pn * BM + wc * 32 + 8 * fq;
#pragma unroll
        for (int ai = 0; ai < 2; ++ai)
#pragma unroll
            for (int m = 0; m < 4; ++m) { const int row = row0 + ai * HALF + m * 16; const float r = row_rs(rp, row);
#pragma unroll
                for (int bj = 0; bj < 2; ++bj) *(u32x4*)(S + (size_t)row * 1024 + col0 + bj * HALF) = pack8(sigm4(acc[ai][bj][m][0] * r), sigm4(acc[ai][bj][m][1] * r)); }
    }
};
struct EpiGateAcc {
    static constexpr bool PERM = true, AFTER_DRAIN = false;
    const bf16_t* S; float* H; bf16_t* XO; float* rp;
    __device__ __forceinline__ void operator()(const f32x4 (&acc)[2][2][4][2], const Unit& u, int wr, int wc, int fr, int fq) const {
        const int row0 = u.pm * BM + wr * 64 + fr, col0 = u.pn * BM + wc * 32 + 8 * fq;
#pragma unroll
        for (int ai = 0; ai < 2; ++ai)
#pragma unroll
            for (int m = 0; m < 4; ++m) { const int row = row0 + ai * HALF + m * 16; float ss = 0.f;
#pragma unroll
                for (int bj = 0; bj < 2; ++bj) { const size_t o = (size_t)row * 1024 + col0 + bj * HALF; f32x4 s0, s1; unpack8(*(const u32x4*)(S + o), s0, s1);
                    const f32x4 h0 = *(const f32x4*)(H + o) + s0 * acc[ai][bj][m][0], h1 = *(const f32x4*)(H + o + 4) + s1 * acc[ai][bj][m][1];
                    *(f32x4*)(H + o) = h0; *(f32x4*)(H + o + 4) = h1; if (XO) *(u32x4*)(XO + o) = pack8(h0, h1); ss += dot4(h0) + dot4(h1); }
                if (rp) { ss += __shfl_xor(ss, 16); ss += __shfl_xor(ss, 32); if (fq == 0) rp[((size_t)u.pn * 16896 + row) * 4 + wc] = ss; } }
    }
};

template <class Epi, class Sched, bool ALIGN_EPI = false, bool SP2 = false>
__device__ __forceinline__ void gemm_phase(PG8_LAS unsigned char* lds, const Gemm g, const Sched& S, const Epi& E) {
    const int tid = threadIdx.x, wid = __builtin_amdgcn_readfirstlane(tid >> 6), lane = tid & 63, wr = wid >> 2, wc = wid & 3, fr = lane & 15, fq = lane >> 4;
    const int K = g.K, nt = K / BK;
    unsigned voffA[2], voffB[2];
#pragma unroll
    for (int i = 0; i < 2; ++i) { int R, C; stage_rc(tid * 16 + i * 8192, R, C); const int Rb = Epi::PERM ? ((R & ~31) + perm32(R & 31)) : R;
        voffA[i] = (unsigned)(R * g.lda + C) * 2u; voffB[i] = (unsigned)(Rb * g.ldb + C) * 2u; }
    const size_t kstep = (size_t)(BK * 2);
    const size_t hstepA = (size_t)HALF * g.lda * 2, hstepB = (size_t)HALF * g.ldb * 2;
    const size_t tstepA = 2 * hstepA, tstepB = 2 * hstepB;
    const unsigned ldsw = (unsigned)wid * 1024u;
    const int aoff = lds_byte(wr * 64 + fr, fq * 8), boff = lds_byte(wc * 32 + fr, fq * 8);
#define PG8_SA(b, h) (((b) * 2 + (h)) * HTB)
#define PG8_SB(b, h) ((4 + (b) * 2 + (h)) * HTB)
#define PG8_STAGE(bufoff, gbase, voff) do { _Pragma("unroll") for (int _i = 0; _i < 2; ++_i) \
        __builtin_amdgcn_global_load_lds((const unsigned*)((const char*)(gbase) + (voff)[_i]), (PG8_LAS unsigned*)(lds + (bufoff) + ldsw + _i * 8192), 16, 0, 0); } while (0)
#define PG8_LDA(dst, b, h) do { _Pragma("unroll") for (int m = 0; m < 4; ++m) _Pragma("unroll") for (int k = 0; k < 2; ++k) dst[m][k] = *(const PG8_LAS bf16x8*)(lds + PG8_SA(b, h) + aoff + m * 2048 + k * 1024); } while (0)
#define PG8_LDB(dst, b, h) do { _Pragma("unroll") for (int n = 0; n < 2; ++n) _Pragma("unroll") for (int k = 0; k < 2; ++k) dst[n][k] = *(const PG8_LAS bf16x8*)(lds + PG8_SB(b, h) + boff + n * 2048 + k * 1024); } while (0)
#define PG8_MMA(ai, bj, At, Bt) do { __builtin_amdgcn_s_setprio(1); _Pragma("unroll") for (int m = 0; m < 4; ++m) _Pragma("unroll") for (int n = 0; n < 2; ++n) _Pragma("unroll") for (int k = 0; k < 2; ++k) \
        acc[ai][bj][m][n] = __builtin_amdgcn_mfma_f32_16x16x32_bf16(Bt[n][k], At[m][k], acc[ai][bj][m][n], 0, 0, 0); __builtin_amdgcn_s_setprio(0); } while (0)
#define PG8_WAIT_V(n) asm volatile("s_waitcnt vmcnt(" #n ")" ::: "memory")
#define PG8_WAIT_L(n) asm volatile("s_waitcnt lgkmcnt(" #n ")" ::: "memory")
#define PG8_BAR __builtin_amdgcn_s_barrier()
#define PG8_SCHED __builtin_amdgcn_sched_barrier(0)
    Unit cur, nxt; int ui = 0;
    if (!S.next(0, cur)) return;
    f32x4 acc[2][2][4][2];
#pragma unroll
    for (int a = 0; a < 2; ++a)
#pragma unroll
        for (int b = 0; b < 2; ++b)
#pragma unroll
            for (int m = 0; m < 4; ++m)
#pragma unroll
                for (int n = 0; n < 2; ++n) acc[a][b][m][n] = (f32x4){0.f, 0.f, 0.f, 0.f};
    bf16x8 At[4][2], B0[2][2], B1[2][2];
    const char* cA = (const char*)g.A + (size_t)cur.pm * tstepA; const char* cB = (const char*)g.Bt + (size_t)cur.pn * tstepB;
    S.a_ready(cur);
    if constexpr (SP2) {
        PG8_STAGE(PG8_SB(0, 0), cB, voffB); PG8_STAGE(PG8_SB(0, 1), cB + hstepB, voffB); PG8_STAGE(PG8_SA(0, 0), cA, voffA); PG8_STAGE(PG8_SA(0, 1), cA + hstepA, voffA);
        if (wr == 1) PG8_BAR;
        PG8_WAIT_V(2); PG8_BAR;
        PG8_STAGE(PG8_SB(1, 0), cB + kstep, voffB); PG8_STAGE(PG8_SA(1, 0), cA + kstep, voffA); PG8_STAGE(PG8_SB(1, 1), cB + hstepB + kstep, voffB);
        PG8_WAIT_V(6); PG8_BAR;
    } else {
        PG8_STAGE(PG8_SB(0, 0), cB, voffB); PG8_STAGE(PG8_SA(0, 0), cA, voffA); PG8_STAGE(PG8_SB(0, 1), cB + hstepB, voffB); PG8_STAGE(PG8_SA(0, 1), cA + hstepA, voffA);
        if (wr == 1) PG8_BAR;
        PG8_WAIT_V(4); PG8_BAR;
        PG8_STAGE(PG8_SB(1, 0), cB + kstep, voffB); PG8_STAGE(PG8_SA(1, 0), cA + kstep, voffA); PG8_STAGE(PG8_SB(1, 1), cB + hstepB + kstep, voffB);
        PG8_WAIT_V(6); PG8_BAR;
    }
    for (;;) {
        const bool has_next = S.next(ui + 1, nxt);
        const char* nA = has_next ? (const char*)g.A + (size_t)nxt.pm * tstepA : cA; const char* nB = has_next ? (const char*)g.Bt + (size_t)nxt.pn * tstepB : cB;
        for (int t = 0; t < nt; t += 2) {
            const bool last = (t == nt - 2);
            const char* a1 = cA + (size_t)(t + 1) * kstep;
            const char* a2 = last ? nA : cA + (size_t)(t + 2) * kstep; const char* b2 = last ? nB : cB + (size_t)(t + 2) * kstep;
            const char* a3 = a2 + kstep; const char* b3 = b2 + kstep;
            if (last && has_next) S.a_ready(nxt);
            if constexpr (SP2) {
            PG8_LDB(B0, 0, 0); PG8_LDB(B1, 0, 1); PG8_SCHED; PG8_LDA(At, 0, 0); PG8_STAGE(PG8_SA(1, 1), a1 + hstepA, voffA);
            PG8_WAIT_V(8); PG8_WAIT_L(0); PG8_BAR; PG8_MMA(0, 0, At, B0); PG8_MMA(0, 1, At, B1); PG8_BAR; PG8_SCHED;
            PG8_LDA(At, 0, 1); PG8_STAGE(PG8_SB(0, 0), b2, voffB); PG8_STAGE(PG8_SB(0, 1), b2 + hstepB, voffB); PG8_STAGE(PG8_SA(0, 0), a2, voffA);
            PG8_WAIT_V(8); PG8_WAIT_L(0); PG8_BAR; PG8_MMA(1, 0, At, B0); PG8_MMA(1, 1, At, B1); PG8_BAR; PG8_SCHED;
            PG8_LDB(B0, 1, 0); PG8_LDB(B1, 1, 1); PG8_SCHED; PG8_LDA(At, 1, 0); PG8_STAGE(PG8_SA(0, 1), a2 + hstepA, voffA);
            PG8_WAIT_V(8); PG8_WAIT_L(0); PG8_BAR; PG8_MMA(0, 0, At, B0); PG8_MMA(0, 1, At, B1); PG8_BAR; PG8_SCHED;
            PG8_LDA(At, 1, 1); PG8_STAGE(PG8_SB(1, 0), b3, voffB); PG8_STAGE(PG8_SB(1, 1), b3 + hstepB, voffB); PG8_STAGE(PG8_SA(1, 0), a3, voffA);
            PG8_WAIT_V(8); PG8_WAIT_L(0); PG8_BAR; PG8_MMA(1, 0, At, B0); PG8_MMA(1, 1, At, B1); PG8_BAR; PG8_SCHED;
            } else {
            PG8_LDB(B0, 0, 0); PG8_SCHED; PG8_LDA(At, 0, 0); PG8_STAGE(PG8_SA(1, 1), a1 + hstepA, voffA);
            PG8_WAIT_L(8); PG8_BAR; PG8_WAIT_L(0); PG8_MMA(0, 0, At, B0); PG8_BAR; PG8_SCHED;
            PG8_LDB(B1, 0, 1); PG8_STAGE(PG8_SB(0, 0), b2, voffB);
            PG8_BAR; PG8_WAIT_L(0); PG8_MMA(0, 1, At, B1); PG8_BAR;
            PG8_LDA(At, 0, 1); PG8_STAGE(PG8_SA(0, 0), a2, voffA);
            PG8_BAR; PG8_WAIT_L(0); PG8_MMA(1, 0, At, B0); PG8_BAR; PG8_SCHED;
            PG8_STAGE(PG8_SB(0, 1), b2 + hstepB, voffB);
            PG8_WAIT_V(6); PG8_BAR; PG8_MMA(1, 1, At, B1); PG8_BAR;
            PG8_LDB(B0, 1, 0); PG8_SCHED; PG8_LDA(At, 1, 0); PG8_STAGE(PG8_SA(0, 1), a2 + hstepA, voffA);
            PG8_WAIT_L(8); PG8_BAR; PG8_WAIT_L(0); PG8_MMA(0, 0, At, B0); PG8_BAR; PG8_SCHED;
            PG8_LDB(B1, 1, 1); PG8_STAGE(PG8_SB(1, 0), b3, voffB);
            PG8_BAR; PG8_WAIT_L(0); PG8_MMA(0, 1, At, B1); PG8_BAR;
            PG8_LDA(At, 1, 1); PG8_STAGE(PG8_SA(1, 0), a3, voffA);
            PG8_BAR; PG8_WAIT_L(0); PG8_MMA(1, 0, At, B0); PG8_BAR; PG8_SCHED;
            PG8_STAGE(PG8_SB(1, 1), b3 + hstepB, voffB);
            PG8_WAIT_V(6); PG8_BAR; PG8_MMA(1, 1, At, B1); PG8_BAR;
            }
        }
        if constexpr (ALIGN_EPI) { if (wr == 0) PG8_BAR; }
        if constexpr (!Epi::AFTER_DRAIN) { E(acc, cur, wr, wc, fr, fq); S.done(cur); }
        if (!has_next) break;
#pragma unroll
        for (int a = 0; a < 2; ++a)
#pragma unroll
            for (int b = 0; b < 2; ++b)
#pragma unroll
                for (int m = 0; m < 4; ++m)
#pragma unroll
                    for (int n = 0; n < 2; ++n) acc[a][b][m][n] = (f32x4){0.f, 0.f, 0.f, 0.f};
        cur = nxt; cA = nA; cB = nB; ++ui;
        if constexpr (ALIGN_EPI) { if (wr == 1) PG8_BAR; }
    }
    PG8_WAIT_V(0);
    if constexpr (!ALIGN_EPI) { if (wr == 0) PG8_BAR; }
    PG8_BAR;
    if constexpr (Epi::AFTER_DRAIN) { E.fused(acc, cur, wr, wc, fr, fq, lds, wid, lane); S.done(cur); }
#undef PG8_SA
#undef PG8_SB
#undef PG8_STAGE
#undef PG8_LDA
#undef PG8_LDB
#undef PG8_MMA
#undef PG8_WAIT_V
#undef PG8_WAIT_L
#undef PG8_BAR
#undef PG8_SCHED
}
}

constexpr int NWAVES = 8;
constexpr size_t MiB = 1u << 20, HMiB = 1u << 19;
constexpr size_t WS_W1T = 1 * MiB, WS_W1OT = 12 * MiB, WS_WQKVT = 17 * MiB + HMiB, WS_WGAT = 24 * MiB, WS_WGRT = 26 * MiB, WS_WOT = 28 * MiB, WS_W2T = 30 * MiB, WS_W2OT = 41 * MiB,
                 WS_WPGT = 46 * MiB + HMiB, WS_WPPT = 48 * MiB + HMiB;
constexpr size_t WS_XN = 49 * MiB, WS_XN2 = 82 * MiB, WS_QK = 115 * MiB, WS_V = 148 * MiB, WS_RG = 181 * MiB, WS_AL = 214 * MiB, WS_G = 115 * MiB;
constexpr size_t WS_RP1 = 230 * MiB + HMiB, WS_RP2 = WS_RP1 + MiB + MiB / 4, WS_RP3 = WS_RP2 + MiB + MiB / 4, WS_COS = WS_RP3 + MiB + MiB / 4, WS_SIN = WS_COS + HMiB, WS_PBF = WS_SIN + HMiB, WS_END = WS_PBF + 9 * MiB;
static_assert(WS_END <= 256 * MiB, "d_ws map");
static_assert(WS_G + (size_t)MT * FF * 2 <= WS_AL, "G overlays QK|V|RG only");
constexpr size_t OUT_YS = (size_t)MP * DM, OUT_GP = OUT_YS + (size_t)MS * DM, OUT_RP = OUT_GP + 262144, OUT_GS = OUT_RP + 262144, OUT_RS = OUT_GS + 4194304;
constexpr int LDS_BYTES = 147456, RING_BYTES = 131072;

#define LAS __attribute__((address_space(3)))
typedef unsigned short bf16;
typedef unsigned v4u __attribute__((ext_vector_type(4)));
typedef float f32x4 __attribute__((ext_vector_type(4)));
typedef short bf16x8 __attribute__((ext_vector_type(8)));
#define LDS_WAIT() asm volatile("s_waitcnt lgkmcnt(0)" ::: "memory")
__device__ __forceinline__ unsigned f2bf(float f) { unsigned u = __builtin_bit_cast(unsigned, f); return (u + 0x7fffu + ((u >> 16) & 1u)) >> 16; }
__device__ __forceinline__ unsigned pk2(float lo, float hi) { return f2bf(lo) | (f2bf(hi) << 16); }
__device__ __forceinline__ float bf2f(unsigned short v) { return __uint_as_float((unsigned)v << 16); }
__device__ __forceinline__ float wave_sum(float v) {
#pragma unroll
    for (int o = 1; o < 64; o <<= 1) v += __shfl_xor(v, o);
    return v;
}
static __device__ const float ROPE_FREQ[32] = {1.000000000e+00f, 7.498942614e-01f, 5.623413324e-01f, 4.216965139e-01f, 3.162277639e-01f, 2.371373773e-01f, 1.778279394e-01f, 1.333521307e-01f, 1.000000015e-01f, 7.498941571e-02f, 5.623413250e-02f, 4.216965288e-02f, 3.162277490e-02f, 2.371373773e-02f, 1.778279431e-02f, 1.333521493e-02f, 9.999999776e-03f, 7.498941850e-03f, 5.623413250e-03f, 4.216964822e-03f, 3.162277630e-03f, 2.371373586e-03f, 1.778279431e-03f, 1.333521446e-03f, 1.000000047e-03f, 7.498942432e-04f, 5.623413017e-04f, 4.216965172e-04f, 3.162277571e-04f, 2.371373703e-04f, 1.778279402e-04f, 1.333521504e-04f};
__device__ __forceinline__ float ret_lg(int h) { return h == 0 ? -0.0317486983145803f : h == 1 ? -0.015748356968139168f : h == 2 ? -0.007843177461025893f : -0.003913899321136329f; }

struct Args { const float* in[23]; float* out; unsigned char* ws; int ph_lo, ph_hi; };

__device__ __forceinline__ void p0_item(const float* W, int N, int k0, int n0, bf16* WT, int K, int drow0, const float* sc, LAS float* scr, int lane) {
#pragma unroll 8
    for (int i = 0; i < 32; ++i) { const int kk = 2 * i + (lane >> 5); float v = W[(size_t)(k0 + kk) * N + n0 + (lane & 31)]; if (sc) v *= sc[k0 + kk]; scr[kk * 33 + (lane & 31)] = v; }
    LDS_WAIT(); asm volatile("" ::: "memory");
    const int c = lane & 7;
#pragma unroll
    for (int j = 0; j < 4; ++j) { const int n = (lane >> 3) + 8 * j; const LAS float* s = scr + (8 * c) * 33 + n;
        v4u o; o.x = pk2(s[0 * 33], s[1 * 33]); o.y = pk2(s[2 * 33], s[3 * 33]); o.z = pk2(s[4 * 33], s[5 * 33]); o.w = pk2(s[6 * 33], s[7 * 33]);
        *(v4u*)(WT + (size_t)(drow0 + n) * K + k0 + 8 * c) = o; }
    LDS_WAIT(); asm volatile("" ::: "memory");
}
__device__ __forceinline__ void p0_ffn_in(const float* W, bf16* WT, const float* sc, int r, LAS float* scr, int lane) {
    const int kb = r / 176, nb = r % 176, n0 = nb * 32, which = n0 / 2816, hid = n0 % 2816;
    p0_item(W, 5632, kb * 64, n0, WT, 1024, (hid / 128) * 256 + which * 128 + (hid % 128), sc, scr, lane);
}
__device__ __forceinline__ void p0_plain(const float* W, int K, int N, bf16* WT, const float* sc, int r, LAS float* scr, int lane) {
    const int nblk = N / 32, kb = r / nblk, nb = r % nblk;
    p0_item(W, N, kb * 64, nb * 32, WT, K, nb * 32, sc, scr, lane);
}
__device__ __forceinline__ void prologue(const Args& a, LAS unsigned char* lds, int vcu, int G, int tid) {
    const int lane = tid & 63, wave = __builtin_amdgcn_readfirstlane(tid >> 6);
    unsigned char* ws = a.ws;
    LAS float* scr = (LAS float*)(lds + wave * 16384);
    const int gw = vcu * NWAVES + wave, NGW = G * NWAVES;
    const float* w_in = a.in[10];
    constexpr int I_A = 2816, I_B = 1408, I_C = 1536, I_D = 512, I_F = 512, I_J = 128;
    constexpr int NITEMS = 2 * I_A + 2 * I_B + I_C + 2 * I_D + 2 * I_F + I_J;
    for (int it = gw; it < NITEMS; it += NGW) {
        int r = it;
        if (r < I_A) { p0_ffn_in(a.in[7], (bf16*)(ws + WS_W1T), nullptr, r, scr, lane); continue; } r -= I_A;
        if (r < I_A) { p0_ffn_in(a.in[17], (bf16*)(ws + WS_W2T), a.in[16], r, scr, lane); continue; } r -= I_A;
        if (r < I_B) { p0_plain(a.in[8], 2816, 1024, (bf16*)(ws + WS_W1OT), nullptr, r, scr, lane); continue; } r -= I_B;
        if (r < I_B) { p0_plain(a.in[18], 2816, 1024, (bf16*)(ws + WS_W2OT), nullptr, r, scr, lane); continue; } r -= I_B;
        if (r < I_C) { const int kb = r / 96, nb = r % 96, n0 = nb * 32; int d0 = n0;
            if (n0 >= 1536 && n0 < 2048) { const int base = n0 < 1792 ? 1536 : 1792, loc = n0 - base; d0 = base + ((loc & 63) >> 5) * 128 + (loc >> 6) * 32; }
            p0_item(w_in, WIN_N, kb * 64, n0, (bf16*)(ws + WS_WQKVT), 1024, d0, a.in[9], scr, lane); continue; } r -= I_C;
        if (r < I_D) { const int kb = r / 32, nb = r % 32; p0_item(w_in, WIN_N, kb * 64, 3088 + nb * 32, (bf16*)(ws + WS_WGAT), 1024, nb * 32, a.in[9], scr, lane); continue; } r -= I_D;
        if (r < I_D) { const int kb = r / 32, nb = r % 32; p0_item(w_in, WIN_N, kb * 64, 4112 + nb * 32, (bf16*)(ws + WS_WGRT), 1024, nb * 32, a.in[9], scr, lane); continue; } r -= I_D;
        if (r < I_F) { p0_plain(a.in[15], 1024, 1024, (bf16*)(ws + WS_WOT), nullptr, r, scr, lane); continue; } r -= I_F;
        if (r < I_F) { p0_plain(a.in[20], 1024, 1024, (bf16*)(ws + WS_WPGT), a.in[19], r, scr, lane); continue; } r -= I_F;
        p0_plain(a.in[21], 256, 1024, (bf16*)(ws + WS_WPPT), nullptr, r, scr, lane);
    }
    const int gt = vcu * (NWAVES * 64) + tid, NGT = G * NWAVES * 64;
    { const float* wau = a.in[11]; const float* nm = a.in[9]; bf16* WT = (bf16*)(ws + WS_WQKVT);
      for (int task = gt; task < 256 * 128; task += NGT) { const int j = task >> 7, k8 = (task & 127) * 8; float wj[16];
#pragma unroll
          for (int r = 0; r < 16; ++r) wj[r] = wau[r * 256 + j];
          float o[8];
#pragma unroll
          for (int kk = 0; kk < 8; ++kk) { const f32x4* p = (const f32x4*)(w_in + (size_t)(k8 + kk) * WIN_N + 3072); float s = 0.f;
#pragma unroll
              for (int q = 0; q < 4; ++q) { const f32x4 x = p[q]; s += x[0] * wj[4 * q] + x[1] * wj[4 * q + 1] + x[2] * wj[4 * q + 2] + x[3] * wj[4 * q + 3]; }
              o[kk] = s * nm[k8 + kk]; }
          v4u w; w.x = pk2(o[0], o[1]); w.y = pk2(o[2], o[3]); w.z = pk2(o[4], o[5]); w.w = pk2(o[6], o[7]);
          *(v4u*)(WT + (size_t)(3072 + j) * 1024 + k8) = w; } }
    { const f32x4* nw = (const f32x4*)a.in[6] + lane; bf16* XN = (bf16*)(ws + WS_XN);
      for (int m = gw; m < MT; m += NGW) { const float* xrow = m < MP ? a.in[0] + (size_t)m * DM : a.in[1] + (size_t)(m - MP) * DM;
          const f32x4* xr = (const f32x4*)xrow + lane; f32x4 v[4]; float s = 0.f;
#pragma unroll
          for (int j = 0; j < 4; ++j) { v[j] = xr[64 * j]; s += pg8::dot4(v[j]); }
          const float rs = rsqrtf(wave_sum(s) * (1.f / DM) + 1e-6f);
          unsigned long long* o8 = (unsigned long long*)(XN + (size_t)m * DM) + lane;
#pragma unroll
          for (int j = 0; j < 4; ++j) { const f32x4 g = nw[64 * j]; o8[64 * j] = (unsigned long long)pk2(v[j][0] * rs * g[0], v[j][1] * rs * g[1]) | ((unsigned long long)pk2(v[j][2] * rs * g[2], v[j][3] * rs * g[3]) << 32); } } }
    { bf16* PB = (bf16*)(ws + WS_PBF);
      for (int task = gt; task < MT * DPLE / 8; task += NGT) { const size_t e = (size_t)task * 8; const float* src = e < (size_t)MP * DPLE ? a.in[4] + e : a.in[5] + (e - (size_t)MP * DPLE);
          const f32x4 x0 = *(const f32x4*)src, x1 = *(const f32x4*)(src + 4); v4u w; w.x = pk2(x0[0], x0[1]); w.y = pk2(x0[2], x0[3]); w.z = pk2(x1[0], x1[1]); w.w = pk2(x1[2], x1[3]);
          *(v4u*)(PB + e) = w; } }
    { float* cT = (float*)(ws + WS_COS); float* sT = (float*)(ws + WS_SIN);
      for (int task = gt; task < 2052 * 32; task += NGT) { const int pi = task >> 5, d = task & 31, pos = pi < 2048 ? pi : 16384 + (pi - 2048);
          const float ang = (float)pos * ROPE_FREQ[d]; double t = (double)ang * 0.15915494309189535; t -= __builtin_rint(t); const float tf = (float)t;
          cT[task] = __builtin_amdgcn_cosf(tf); sT[task] = __builtin_amdgcn_sinf(tf); } }
}

constexpr int LQ = 72, LO = 136;
constexpr int S_Q = 0, S_K = 9216, S_KT = 18432, S_VT = 27648, S_P = 46080, S_ST = 55296, S_O = 73728, S_TOT = 91136, S_LAM = 93184, S_PART = 93440;
#define MFMA16(a, b, c) __builtin_amdgcn_mfma_f32_16x16x32_bf16(a, b, c, 0, 0, 0)
__device__ __forceinline__ void scan_prompt(LAS unsigned char* lds, int item, const Args& a, int tid) {
    const int b = item >> 3, hb = item & 7, br = hb >> 2, h = hb & 3;
    const int lane = tid & 63, w = __builtin_amdgcn_readfirstlane(tid >> 6), fr = lane & 15, fq = lane >> 4;
    unsigned char* ws = a.ws;
    const bf16* QK = (const bf16*)(ws + WS_QK); const bf16* V = (const bf16*)(ws + WS_V); bf16* RG = (bf16*)(ws + WS_RG); const float* AL = (const float*)(ws + WS_AL);
    LAS bf16* sQ = (LAS bf16*)(lds + S_Q); LAS bf16* sK = (LAS bf16*)(lds + S_K); LAS bf16* sKT = (LAS bf16*)(lds + S_KT); LAS bf16* sVT = (LAS bf16*)(lds + S_VT);
    LAS bf16* sP = (LAS bf16*)(lds + S_P); LAS bf16* sST = (LAS bf16*)(lds + S_ST); LAS bf16* sO = (LAS bf16*)(lds + S_O);
    LAS float* sTOT = (LAS float*)(lds + S_TOT); LAS float* sLAM = (LAS float*)(lds + S_LAM); LAS float* sPART = (LAS float*)(lds + S_PART);
    const float lg = ret_lg(h);
    const int qoff = br * 512 + h * 64, koff = qoff + 256, voff = br * 512 + h * 128;
    const float gnw = (br ? a.in[14] : a.in[13])[h * 128 + w * 16 + fr];
    f32x4 accS[4];
#pragma unroll
    for (int i = 0; i < 4; ++i) accS[i] = (f32x4){0.f, 0.f, 0.f, 0.f};
    for (int i = tid; i < 128 * LQ / 2; i += 512) ((LAS unsigned*)(lds + S_ST))[i] = 0u;
    unsigned short pq[8], pk[8]; float pg[8]; v4u pv[2], pr[2];
#define SCAN_PREFETCH(ch) do { const size_t row0_ = (size_t)b * 2048 + (size_t)(ch) * 64; \
        _Pragma("unroll") for (int i = 0; i < 8; ++i) { const size_t row = row0_ + w * 8 + i; pq[i] = QK[row * 1024 + qoff + lane]; pk[i] = QK[row * 1024 + koff + lane]; pg[i] = br ? lg : AL[row * 256 + h * 64 + lane]; } \
        _Pragma("unroll") for (int j = 0; j < 2; ++j) { const int p = tid + j * 512, t = p >> 4, c8 = (p & 15) * 8; pv[j] = *(const v4u*)(V + (row0_ + t) * 1024 + voff + c8); pr[j] = *(const v4u*)(RG + (row0_ + t) * 1024 + voff + c8); } } while (0)
    SCAN_PREFETCH(0);
    for (int ch = 0; ch < 32; ++ch) {
        const size_t row0 = (size_t)b * 2048 + (size_t)ch * 64;
        float bl[8], qf[8], kf[8]; float run = 0.f;
#pragma unroll
        for (int i = 0; i < 8; ++i) { run += pg[i]; bl[i] = run; qf[i] = bf2f(pq[i]); kf[i] = bf2f(pk[i]); }
        sTOT[w * 64 + lane] = run;
        __syncthreads();
        float off = 0.f, tot = 0.f;
#pragma unroll
        for (int s = 0; s < 8; ++s) { const float x = sTOT[s * 64 + lane]; tot += x; if (s < w) off += x; }
#pragma unroll
        for (int i = 0; i < 8; ++i) { const int t = w * 8 + i; const float bb = off + bl[i];
            sQ[t * LQ + lane] = (bf16)f2bf(qf[i] * __expf(bb)); sK[t * LQ + lane] = (bf16)f2bf(kf[i] * __expf(-bb)); sKT[lane * LQ + t] = (bf16)f2bf(kf[i] * __expf(tot - bb)); }
        if (w == 0) sLAM[lane] = __expf(tot);
#pragma unroll
        for (int j = 0; j < 2; ++j) { const int p = tid + j * 512, t = p >> 4, c8 = (p & 15) * 8; const v4u x = pv[j];
            sVT[(c8 + 0) * LQ + t] = (bf16)(x.x & 0xffffu); sVT[(c8 + 1) * LQ + t] = (bf16)(x.x >> 16); sVT[(c8 + 2) * LQ + t] = (bf16)(x.y & 0xffffu); sVT[(c8 + 3) * LQ + t] = (bf16)(x.y >> 16);
            sVT[(c8 + 4) * LQ + t] = (bf16)(x.z & 0xffffu); sVT[(c8 + 5) * LQ + t] = (bf16)(x.z >> 16); sVT[(c8 + 6) * LQ + t] = (bf16)(x.w & 0xffffu); sVT[(c8 + 7) * LQ + t] = (bf16)(x.w >> 16); }
        v4u rr[2]; rr[0] = pr[0]; rr[1] = pr[1];
        if (ch + 1 < 32) SCAN_PREFETCH(ch + 1);
        __syncthreads();
        { const int it = w >> 1;
#pragma unroll
          for (int jj = 0; jj < 2; ++jj) { const int jt = (w & 1) * 2 + jj; f32x4 p = (f32x4){0.f, 0.f, 0.f, 0.f};
              if (jt <= it) {
#pragma unroll
                  for (int ks = 0; ks < 2; ++ks) { const bf16x8 x = *(const LAS bf16x8*)(sQ + (it * 16 + fr) * LQ + ks * 32 + fq * 8), y = *(const LAS bf16x8*)(sK + (jt * 16 + fr) * LQ + ks * 32 + fq * 8); p = MFMA16(x, y, p); } }
#pragma unroll
              for (int r = 0; r < 4; ++r) { const int gi = it * 16 + 4 * fq + r, gj = jt * 16 + fr; sP[gi * LQ + gj] = (bf16)f2bf(gj <= gi ? p[r] : 0.f); } } }
#pragma unroll
        for (int dt = 0; dt < 4; ++dt) { const float lam = sLAM[dt * 16 + fr]; accS[dt] = accS[dt] * lam;
#pragma unroll
            for (int ks = 0; ks < 2; ++ks) { const bf16x8 x = *(const LAS bf16x8*)(sVT + (w * 16 + fr) * LQ + ks * 32 + fq * 8), y = *(const LAS bf16x8*)(sKT + (dt * 16 + fr) * LQ + ks * 32 + fq * 8); accS[dt] = MFMA16(x, y, accS[dt]); } }
        __syncthreads();
        f32x4 accO[4];
        { bf16x8 bv[2], bs[2];
#pragma unroll
          for (int ks = 0; ks < 2; ++ks) { bv[ks] = *(const LAS bf16x8*)(sVT + (w * 16 + fr) * LQ + ks * 32 + fq * 8); bs[ks] = *(const LAS bf16x8*)(sST + (w * 16 + fr) * LQ + ks * 32 + fq * 8); }
#pragma unroll
          for (int it = 0; it < 4; ++it) { f32x4 o = (f32x4){0.f, 0.f, 0.f, 0.f};
#pragma unroll
              for (int ks = 0; ks < 2; ++ks) { const bf16x8 x = *(const LAS bf16x8*)(sP + (it * 16 + fr) * LQ + ks * 32 + fq * 8); o = MFMA16(x, bv[ks], o); }
#pragma unroll
              for (int ks = 0; ks < 2; ++ks) { const bf16x8 x = *(const LAS bf16x8*)(sQ + (it * 16 + fr) * LQ + ks * 32 + fq * 8); o = MFMA16(x, bs[ks], o); }
              accO[it] = o;
#pragma unroll
              for (int r = 0; r < 4; ++r) { float s = o[r] * o[r]; s += __shfl_xor(s, 1); s += __shfl_xor(s, 2); s += __shfl_xor(s, 4); s += __shfl_xor(s, 8); if (fr == 0) sPART[(it * 16 + 4 * fq + r) * 8 + w] = s; } } }
        __syncthreads();
#pragma unroll
        for (int it = 0; it < 4; ++it)
#pragma unroll
            for (int r = 0; r < 4; ++r) { const int i = it * 16 + 4 * fq + r; const f32x4 p0 = *(const LAS f32x4*)(sPART + i * 8), p1 = *(const LAS f32x4*)(sPART + i * 8 + 4);
                const float ss = ((p0[0] + p0[1]) + (p0[2] + p0[3])) + ((p1[0] + p1[1]) + (p1[2] + p1[3])); const float rs = rsqrtf(ss * (1.0f / 128.0f) + 1e-6f);
                sO[i * LO + w * 16 + fr] = (bf16)f2bf(accO[it][r] * rs * gnw); }
#pragma unroll
        for (int dt = 0; dt < 4; ++dt)
#pragma unroll
            for (int r = 0; r < 4; ++r) sST[(w * 16 + 4 * fq + r) * LQ + dt * 16 + fr] = (bf16)f2bf(accS[dt][r]);
        __syncthreads();
#pragma unroll
        for (int j = 0; j < 2; ++j) { const int p = tid + j * 512, i = p >> 4, c8 = (p & 15) * 8; const v4u o8 = *(const LAS v4u*)(sO + i * LO + c8); const v4u g8 = rr[j]; v4u w8;
            w8.x = pk2(__uint_as_float(o8.x << 16) * __uint_as_float(g8.x << 16), __uint_as_float(o8.x & 0xffff0000u) * __uint_as_float(g8.x & 0xffff0000u));
            w8.y = pk2(__uint_as_float(o8.y << 16) * __uint_as_float(g8.y << 16), __uint_as_float(o8.y & 0xffff0000u) * __uint_as_float(g8.y & 0xffff0000u));
            w8.z = pk2(__uint_as_float(o8.z << 16) * __uint_as_float(g8.z << 16), __uint_as_float(o8.z & 0xffff0000u) * __uint_as_float(g8.z & 0xffff0000u));
            w8.w = pk2(__uint_as_float(o8.w << 16) * __uint_as_float(g8.w << 16), __uint_as_float(o8.w & 0xffff0000u) * __uint_as_float(g8.w & 0xffff0000u));
            *(v4u*)(RG + (row0 + i) * 1024 + voff + c8) = w8; }
    }
#undef SCAN_PREFETCH
    float* so = a.out + (br ? OUT_RP : OUT_GP) + (size_t)(b * 4 + h) * 8192;
#pragma unroll
    for (int dt = 0; dt < 4; ++dt)
#pragma unroll
        for (int r = 0; r < 4; ++r) so[(dt * 16 + fr) * 128 + w * 16 + 4 * fq + r] = accS[dt][r];
    __syncthreads();
}
__device__ __forceinline__ void scan_sample(LAS unsigned char* lds, int item, const Args& a, int tid) {
    const int bs = item >> 3, hb = item & 7, br = hb >> 2, h = hb & 3;
    const int lane = tid & 63, w = __builtin_amdgcn_readfirstlane(tid >> 6);
    unsigned char* ws = a.ws;
    const bf16* QK = (const bf16*)(ws + WS_QK); const bf16* Vb = (const bf16*)(ws + WS_V); bf16* RG = (bf16*)(ws + WS_RG); const float* AL = (const float*)(ws + WS_AL);
    LAS float* L = (LAS float*)lds;
    LAS float* sQ = L; LAS float* sK = L + 256; LAS float* sG = L + 512; LAS float* sV = L + 768; LAS float* sGT = L + 1280; LAS float* sQT = L + 1792; LAS float* sKH = L + 2048;
    LAS float* sLAM = L + 2304; LAS float* sPP = L + 2368; LAS float* sOP = L + 2384; LAS float* sSS = L + 4432;
    const size_t row0 = (size_t)MP + (size_t)bs * 4;
    const int qoff = br * 512 + h * 64, koff = qoff + 256, voff = br * 512 + h * 128;
    const float* S0 = (br ? a.in[3] : a.in[2]) + (size_t)(bs * 4 + h) * 8192;
    float* S1 = a.out + (br ? OUT_RS : OUT_GS) + (size_t)(bs * 4 + h) * 8192;
    const float* gn = (br ? a.in[14] : a.in[13]) + h * 128;
    const int c = tid & 127, dq = tid >> 7;
    float s0[16];
#pragma unroll
    for (int dd = 0; dd < 16; ++dd) s0[dd] = S0[(dq * 16 + dd) * 128 + c];
    if (tid < 256) { const int t = tid >> 6, d = tid & 63; const size_t row = row0 + t; sQ[t * 64 + d] = bf2f(QK[row * 1024 + qoff + d]); sK[t * 64 + d] = bf2f(QK[row * 1024 + koff + d]); sG[t * 64 + d] = br ? ret_lg(h) : AL[row * 256 + h * 64 + d]; }
    { const int t = tid >> 7; sV[t * 128 + c] = bf2f(Vb[(row0 + t) * 1024 + voff + c]); sGT[t * 128 + c] = bf2f(RG[(row0 + t) * 1024 + voff + c]); }
    const float gnc = gn[c];
    __syncthreads();
    if (tid < 64) { const int d = tid; float bc[4]; float run = 0.f;
#pragma unroll
        for (int t = 0; t < 4; ++t) { run += sG[t * 64 + d]; bc[t] = run; }
#pragma unroll
        for (int t = 0; t < 4; ++t) { sQT[t * 64 + d] = sQ[t * 64 + d] * __expf(bc[t]); sKH[t * 64 + d] = sK[t * 64 + d] * __expf(bc[3] - bc[t]); }
        sLAM[d] = __expf(bc[3]);
#pragma unroll
        for (int t = 0; t < 4; ++t)
#pragma unroll
            for (int j = 0; j < 4; ++j) if (j <= t) { float p = sQ[t * 64 + d] * sK[j * 64 + d] * __expf(bc[t] - bc[j]); p = wave_sum(p); if (d == 0) sPP[t * 4 + j] = p; } }
    __syncthreads();
    { float po[4] = {0.f, 0.f, 0.f, 0.f}; float vj[4];
#pragma unroll
      for (int j = 0; j < 4; ++j) vj[j] = sV[j * 128 + c];
#pragma unroll
      for (int dd = 0; dd < 16; ++dd) { const int d = dq * 16 + dd; const float s = s0[dd];
#pragma unroll
          for (int t = 0; t < 4; ++t) po[t] += sQT[t * 64 + d] * s;
          float sn = sLAM[d] * s;
#pragma unroll
          for (int j = 0; j < 4; ++j) sn += sKH[j * 64 + d] * vj[j];
          S1[d * 128 + c] = sn; }
#pragma unroll
      for (int t = 0; t < 4; ++t) sOP[(dq * 4 + t) * 128 + c] = po[t]; }
    __syncthreads();
    { const int t = tid >> 7; float o = (sOP[(0 * 4 + t) * 128 + c] + sOP[(1 * 4 + t) * 128 + c]) + (sOP[(2 * 4 + t) * 128 + c] + sOP[(3 * 4 + t) * 128 + c]);
#pragma unroll
      for (int j = 0; j < 4; ++j) if (j <= t) o += sPP[t * 4 + j] * sV[j * 128 + c];
      const float ss = wave_sum(o * o); if (lane == 0) sSS[w] = ss;
      __syncthreads();
      const float rs = rsqrtf((sSS[2 * t] + sSS[2 * t + 1]) * (1.0f / 128.0f) + 1e-6f);
      RG[(row0 + t) * 1024 + voff + c] = (bf16)f2bf(o * rs * gnc * sGT[t * 128 + c]); }
    __syncthreads();
}

#define XB_TMO      128
#define XB_XCNT(j)  (256  + 64 * (j))
#define XB_XSUB(j)  (1280 + 64 * (j))
#define XB_XGEN(j)  (2304 + 64 * (j))
#define XB_TOP      3328
#define XB_TOPGEN   3392
#define XCD_BAR_WORDS 3456
#define XB_SPIN_CAP (1u << 18)

__device__ __forceinline__ unsigned xb_ld(unsigned* p)              { return __hip_atomic_load(p, __ATOMIC_RELAXED, __HIP_MEMORY_SCOPE_AGENT); }
__device__ __forceinline__ unsigned xb_add(unsigned* p, unsigned v) { return __hip_atomic_fetch_add(p, v, __ATOMIC_RELAXED, __HIP_MEMORY_SCOPE_AGENT); }
__device__ __forceinline__ unsigned xb_xcc_id() { return (unsigned)__builtin_amdgcn_s_getreg((3 << 11) | 20) & 0xFu; }
#define XB_SPIN(cond, bar) do { unsigned _sp = 0; while (cond) { __builtin_amdgcn_s_sleep(1); \
    if ((++_sp & 255u) == 0u) { if (xb_ld(&(bar)[XB_TMO])) break; if (_sp > XB_SPIN_CAP) { atomicAdd(&(bar)[XB_TMO], 1u); break; } } } } while (0)

struct XcdBarrier {
    unsigned* bar; unsigned x;
    volatile LAS unsigned* st;
};

__device__ __forceinline__ XcdBarrier xcd_barrier_post(unsigned* bar, volatile LAS unsigned* st) {
    XcdBarrier b; b.bar = bar; b.x = xb_xcc_id(); b.st = st;
    if (threadIdx.x == 0) (void)xb_add(&bar[XB_XCNT(b.x)], 1u);
    return b;
}
__device__ __forceinline__ void xcd_barrier_complete(unsigned* bar, unsigned x, unsigned& nloc, unsigned& nx) {
    const unsigned G = gridDim.x * gridDim.y * gridDim.z;
    unsigned sum, cnt, mine, sp = 0u;
    for (;;) {
        sum = 0u; cnt = 0u; mine = 0u;
#pragma unroll
        for (unsigned j = 0; j < 16; ++j) { const unsigned c = xb_ld(&bar[XB_XCNT(j)]); sum += c; cnt += (c > 0u) ? 1u : 0u; mine = (j == x) ? c : mine; }
        if (sum == G) break;
        __builtin_amdgcn_s_sleep(1);
        if ((++sp & 255u) == 0u) { if (xb_ld(&bar[XB_TMO])) break; if (sp > XB_SPIN_CAP) { atomicAdd(&bar[XB_TMO], 1u); break; } }
    }
    nloc = mine > 0u ? mine : 1u; nx = cnt > 0u ? cnt : 1u;
}

__device__ __forceinline__ void xcd_barrier(const XcdBarrier& b) {
    asm volatile("s_waitcnt vmcnt(0)" ::: "memory");
    __syncthreads();
    if (threadIdx.x == 0) {
        unsigned* bar = b.bar;
        __builtin_amdgcn_s_waitcnt(0);
        unsigned nloc = b.st[0], nx = b.st[1];
        if (nloc == 0u) { xcd_barrier_complete(bar, b.x, nloc, nx); b.st[0] = nloc; b.st[1] = nx; }
        const unsigned old = xb_add(&bar[XB_XSUB(b.x)], 1u);
        const unsigned gen = old / nloc;
        if (old + 1u == (gen + 1u) * nloc) {
            __builtin_amdgcn_fence(__ATOMIC_RELEASE, "agent");
            asm volatile("s_waitcnt vmcnt(0)" ::: "memory");
            const unsigned og = xb_add(&bar[XB_TOP], 1u);
            const unsigned tg = og / nx;
            if (og + 1u == (tg + 1u) * nx) xb_add(&bar[XB_TOPGEN], 1u);
            else XB_SPIN(xb_ld(&bar[XB_TOPGEN]) == tg, bar);
            __builtin_amdgcn_fence(__ATOMIC_ACQUIRE, "agent");
            xb_add(&bar[XB_XGEN(b.x)], 1u);
            asm volatile("s_waitcnt vmcnt(0)" ::: "memory");
        } else {
            XB_SPIN(xb_ld(&bar[XB_XGEN(b.x)]) == gen, bar);
            __builtin_amdgcn_fence(__ATOMIC_ACQUIRE, "agent");
            asm volatile("s_waitcnt vmcnt(0)" ::: "memory");
        }
    }
    __syncthreads();
}

__global__ void __launch_bounds__(NWAVES * 64, 2) mk_fwd(Args args) {
    extern __shared__ __attribute__((aligned(16))) unsigned char lds_raw[];
    LAS unsigned char* lds = (LAS unsigned char*)lds_raw;
    const int tid = threadIdx.x, lane = tid & 63, wave = __builtin_amdgcn_readfirstlane(tid >> 6);
    const int G = gridDim.x, bx = blockIdx.x, vcu = (G % 8 == 0) ? (bx % 8) * (G / 8) + bx / 8 : bx;
    unsigned char* ws = args.ws;
    const int lo = args.ph_lo, hi = args.ph_hi;
#define IN(k) (lo <= (k) && (k) < hi)
#if MK_SINGLE
    volatile LAS unsigned* MISC = (volatile LAS unsigned*)(lds + RING_BYTES + 320);
    if (tid < 64) ((LAS unsigned*)(lds + RING_BYTES))[tid + 64] = 0u;
    __syncthreads();
    XcdBarrier bar = xcd_barrier_post((unsigned*)ws + 4096, MISC + 8);
    if (hi > 1000) cg::this_grid().sync();
#define SEAM(k) do { if (IN(k) && IN((k) + 1)) xcd_barrier(bar); } while (0)
#else
#define SEAM(k) do { } while (0)
#endif
    bf16* XN = (bf16*)(ws + WS_XN); bf16* XN2 = (bf16*)(ws + WS_XN2); bf16* GB = (bf16*)(ws + WS_G);
    bf16* QK = (bf16*)(ws + WS_QK); bf16* VB = (bf16*)(ws + WS_V); bf16* RG = (bf16*)(ws + WS_RG); float* AL = (float*)(ws + WS_AL);
    float* RP1 = (float*)(ws + WS_RP1); float* RP2 = (float*)(ws + WS_RP2); float* RP3 = (float*)(ws + WS_RP3);
    float* H = args.out;

    if (IN(0)) { prologue(args, lds, vcu, G, tid); } SEAM(0);
    if (IN(1)) {
        pg8::Gemm g{XN, (const bf16*)(ws + WS_W1T), MT, 2 * FF, DM, DM, DM}; pg8::StaticOrder S; S.init(MT, 2 * FF, G, bx);
        pg8::EpiSwiGLU E{GB, nullptr};
        pg8::gemm_phase<pg8::EpiSwiGLU, pg8::StaticOrder, true, true>(lds, g, S, E);
    } SEAM(1);
    if (IN(2)) {
        pg8::Gemm g{GB, (const bf16*)(ws + WS_W1OT), MT, DM, FF, FF, FF}; pg8::StaticOrder S; S.init(MT, DM, G, bx);
        pg8::EpiResid E{args.in[0], args.in[1], H, XN, RP1};
        pg8::gemm_phase<pg8::EpiResid, pg8::StaticOrder, true, true>(lds, g, S, E);
    } SEAM(2);
    if (IN(3)) {
        pg8::Gemm g{XN, (const bf16*)(ws + WS_WQKVT), MT, NQKV, DM, DM, DM}; pg8::StaticOrder S; S.init(MT, NQKV, G, bx);
        pg8::EpiQKV E{QK, VB, RG, AL, RP1, args.in[12], (const float*)(ws + WS_COS), (const float*)(ws + WS_SIN)};
        pg8::gemm_phase<pg8::EpiQKV, pg8::StaticOrder, true, true>(lds, g, S, E);
    } SEAM(3);
    if (IN(4)) {
        if (G >= 128) { if (bx < 64) scan_prompt(lds, bx, args, tid); else for (int it = bx - 64; it < 1024; it += G - 64) scan_sample(lds, it, args, tid); }
        else { for (int it = bx; it < 64; it += G) scan_prompt(lds, it, args, tid); for (int it = bx; it < 1024; it += G) scan_sample(lds, it, args, tid); }
    } SEAM(4);
    if (IN(5)) {
        pg8::StaticOrder S; S.init(MT, DM, G, bx);
        { pg8::Gemm g{XN, (const bf16*)(ws + WS_WGAT), MT, DM, DM, DM, DM}; pg8::EpiSig E{QK, RP1}; pg8::gemm_phase<pg8::EpiSig, pg8::StaticOrder, true, true>(lds, g, S, E); }
        { pg8::Gemm g{XN, (const bf16*)(ws + WS_WGRT), MT, DM, DM, DM, DM}; pg8::EpiSig E{VB, RP1}; pg8::gemm_phase<pg8::EpiSig, pg8::StaticOrder, true, true>(lds, g, S, E); }
        { pg8::Gemm g{RG, (const bf16*)(ws + WS_WOT), MT, DM, 512, DM, DM}; pg8::EpiGateAcc E{QK, H, nullptr, nullptr}; pg8::gemm_phase<pg8::EpiGateAcc, pg8::StaticOrder, true, true>(lds, g, S, E); }
        { pg8::Gemm g{RG + 512, (const bf16*)(ws + WS_WOT) + 512, MT, DM, 512, DM, DM}; pg8::EpiGateAcc E{VB, H, XN2, RP2}; pg8::gemm_phase<pg8::EpiGateAcc, pg8::StaticOrder, true, true>(lds, g, S, E); }
    } SEAM(5);
    if (IN(6)) {
        pg8::Gemm g{XN2, (const bf16*)(ws + WS_W2T), MT, 2 * FF, DM, DM, DM}; pg8::StaticOrder S; S.init(MT, 2 * FF, G, bx);
        pg8::EpiSwiGLU E{GB, RP2};
        pg8::gemm_phase<pg8::EpiSwiGLU, pg8::StaticOrder, true, true>(lds, g, S, E);
    } SEAM(6);
    if (IN(7)) {
        pg8::Gemm g{GB, (const bf16*)(ws + WS_W2OT), MT, DM, FF, FF, FF}; pg8::StaticOrder S; S.init(MT, DM, G, bx);
        pg8::EpiResid E{H, H + (size_t)MP * DM, H, XN, RP3};
        pg8::gemm_phase<pg8::EpiResid, pg8::StaticOrder, true, true>(lds, g, S, E);
    } SEAM(7);
    if (IN(8)) {
        pg8::StaticOrder S; S.init(MT, DM, G, bx);
        { pg8::Gemm g{XN, (const bf16*)(ws + WS_WPGT), MT, DM, DM, DM, DM}; pg8::EpiSig E{QK, RP3}; pg8::gemm_phase<pg8::EpiSig, pg8::StaticOrder, true, true>(lds, g, S, E); }
        { pg8::Gemm g{(const bf16*)(ws + WS_PBF), (const bf16*)(ws + WS_WPPT), MT, DM, DPLE, DPLE, DPLE}; pg8::EpiGateAcc E{QK, H, nullptr, nullptr}; pg8::gemm_phase<pg8::EpiGateAcc, pg8::StaticOrder, true, true>(lds, g, S, E); }
    } SEAM(8);
    if (IN(9)) {
        const f32x4* nw = (const f32x4*)args.in[22] + lane; const int gw = vcu * NWAVES + wave, NGW = G * NWAVES;
        for (int m = gw; m < MT; m += NGW) { f32x4* xr = (f32x4*)(H + (size_t)m * DM) + lane; f32x4 v[4]; float s = 0.f;
#pragma unroll
            for (int j = 0; j < 4; ++j) { v[j] = xr[64 * j]; s += pg8::dot4(v[j]); }
            const float rs = rsqrtf(wave_sum(s) * (1.f / DM) + 1e-6f);
#pragma unroll
            for (int j = 0; j < 4; ++j) xr[64 * j] = v[j] * rs * nw[64 * j]; }
    }
#undef IN
#undef SEAM
}

extern "C" void kernel_launch(void* const* d_in, const int* in_sizes, int n_in, void* d_out, int out_size, void* d_ws, size_t ws_size, hipStream_t stream) {
    static int grid = 0;
    if (grid == 0) {
        if (n_in != 23 || ws_size < WS_END) { fprintf(stderr, "kernel_launch: unexpected inputs (n_in %d, ws %zu)\n", n_in, ws_size); grid = -1; return; }
        int dev = 0, cus = 0, per_cu = 0;
        if (hipGetDevice(&dev) != hipSuccess || hipDeviceGetAttribute(&cus, hipDeviceAttributeMultiprocessorCount, dev) != hipSuccess) { grid = -1; return; }
        if (hipFuncSetAttribute((const void*)mk_fwd, hipFuncAttributeMaxDynamicSharedMemorySize, LDS_BYTES) != hipSuccess) { fprintf(stderr, "kernel_launch: hipFuncSetAttribute failed\n"); grid = -1; return; }
        if (hipOccupancyMaxActiveBlocksPerMultiprocessor(&per_cu, (const void*)mk_fwd, NWAVES * 64, LDS_BYTES) != hipSuccess || per_cu < 1) { per_cu = 1; (void)hipGetLastError(); }
        grid = cus * 1;
    }
    if (grid < 0) return;
    Args a{};
    for (int i = 0; i < 23; ++i) a.in[i] = (const float*)d_in[i];
    a.out = (float*)d_out; a.ws = (unsigned char*)d_ws;
#if MK_SINGLE
    if (hipMemsetAsync(d_ws, 0, 65536, stream) != hipSuccess) { fprintf(stderr, "kernel_launch: hipMemsetAsync failed\n"); return; }
    a.ph_lo = 0; a.ph_hi = 10;
    void* kargs[] = {&a};
    hipError_t e = hipLaunchCooperativeKernel((const void*)mk_fwd, dim3(grid), dim3(NWAVES * 64), kargs, LDS_BYTES, stream);
    if (e != hipSuccess) fprintf(stderr, "kernel_launch: cooperative launch failed: %s (grid %d)\n", hipGetErrorString(e), grid);
#else
    for (int p = 0; p < 10; ++p) { a.ph_lo = p; a.ph_hi = p + 1; hipLaunchKernelGGL(mk_fwd, dim3(grid), dim3(NWAVES * 64), LDS_BYTES, stream, a); }
#endif
}
```

```cpp
#include <hip/hip_runtime.h>
#include <hip/hip_cooperative_groups.h>
#include <cstdio>
#include <cstdint>
namespace cg = cooperative_groups;
#ifndef MK_SINGLE
#define MK_SINGLE 1
#endif
constexpr int MP = 16384, MS = 512, MT = MP + MS, DM = 1024, FF = 2816, NQKV = 3328, DPLE = 256, WIN_N = 5136;
namespace pg8 {
#define PG8_LAS __attribute__((address_space(3)))
typedef unsigned short bf16_t;
typedef short bf16x8 __attribute__((ext_vector_type(8)));
typedef float f32x4 __attribute__((ext_vector_type(4)));
typedef unsigned u32x4 __attribute__((ext_vector_type(4)));
constexpr int BM = 256, BK = 64, HALF = 128, HTB = HALF * BK * 2  , STAGE_BYTES = 8 * HTB, NXCD = 8, WGM = 8;

__host__ __device__ __forceinline__ int lds_byte(int r, int c) { const int st = (r >> 4) * 2 + (c >> 5), rr = r & 15, cc = c & 31, ob = rr * 64 + cc * 2; return st * 1024 + (ob ^ (((ob >> 9) & 1) << 5)); }
__host__ __device__ __forceinline__ void stage_rc(int b, int& R, int& C) { const int st = b / 1024, sb = b % 1024, swz = sb ^ (((sb >> 9) & 1) << 5); R = (st >> 1) * 16 + swz / 64; C = (st & 1) * 32 + (swz % 64) / 2; }
__host__ __device__ __forceinline__ int perm32(int rho) { const int n = rho >> 4, i = rho & 15; return 8 * (i >> 2) + 4 * n + (i & 3); }

struct Unit { int pm, pn; };
struct Gemm { const bf16_t* A; const bf16_t* Bt; int M, N, K, lda, ldb; };

struct StaticOrder {
    int nM, nN, nwg, G, c;
    __host__ __device__ void init(int M, int N, int G_, int c_) { nM = M / BM; nN = N / BM; nwg = nM * nN; G = G_; c = c_; }
    __host__ __device__ bool next(int i, Unit& u) const {
        const long L = (long)i * G + c; if (L >= nwg) return false;
        int wgid = (int)L; { const int q = nwg / NXCD, r = nwg % NXCD, xcd = wgid % NXCD, off = wgid / NXCD; wgid = (xcd < r ? xcd * (q + 1) : r * (q + 1) + (xcd - r) * q) + off; }
        const int nig = WGM * nN, gid = wgid / nig, fm = gid * WGM, gsz = (nM - fm) < WGM ? (nM - fm) : WGM;
        u.pm = fm + ((wgid % nig) % gsz); u.pn = (wgid % nig) / gsz; return true;
    }
    __device__ __forceinline__ void a_ready(const Unit&) const {}
    __device__ __forceinline__ void done(const Unit&) const {}
};


__device__ __forceinline__ unsigned cvt_pk_bf16(float lo, float hi) { unsigned r; asm volatile("v_cvt_pk_bf16_f32 %0, %1, %2" : "=v"(r) : "v"(lo), "v"(hi)); return r; }
__device__ __forceinline__ u32x4 pack8(const f32x4 a, const f32x4 b) { u32x4 w; w.x = cvt_pk_bf16(a[0], a[1]); w.y = cvt_pk_bf16(a[2], a[3]); w.z = cvt_pk_bf16(b[0], b[1]); w.w = cvt_pk_bf16(b[2], b[3]); return w; }
__device__ __forceinline__ void unpack8(const u32x4 w, f32x4& a, f32x4& b) {
    a[0] = __uint_as_float(w.x << 16); a[1] = __uint_as_float(w.x & 0xffff0000u); a[2] = __uint_as_float(w.y << 16); a[3] = __uint_as_float(w.y & 0xffff0000u);
    b[0] = __uint_as_float(w.z << 16); b[1] = __uint_as_float(w.z & 0xffff0000u); b[2] = __uint_as_float(w.w << 16); b[3] = __uint_as_float(w.w & 0xffff0000u); }
__device__ __forceinline__ float sigm(float x) { return __builtin_amdgcn_rcpf(1.0f + __builtin_amdgcn_exp2f(-1.4426950408889634f * x)); }
__device__ __forceinline__ f32x4 sigm4(const f32x4 x) { f32x4 r; r[0] = sigm(x[0]); r[1] = sigm(x[1]); r[2] = sigm(x[2]); r[3] = sigm(x[3]); return r; }
__device__ __forceinline__ f32x4 silu4(const f32x4 x) { return x * sigm4(x); }
__device__ __forceinline__ float dot4(const f32x4 a) { return (a[0] * a[0] + a[1] * a[1]) + (a[2] * a[2] + a[3] * a[3]); }
__device__ __forceinline__ float row_rs(const float* rp, int row) {
    const f32x4 a = *(const f32x4*)(rp + ((size_t)0 * 16896 + row) * 4), b = *(const f32x4*)(rp + ((size_t)1 * 16896 + row) * 4), c = *(const f32x4*)(rp + ((size_t)2 * 16896 + row) * 4), d = *(const f32x4*)(rp + ((size_t)3 * 16896 + row) * 4);
    const float s = (((a[0] + a[1]) + (a[2] + a[3])) + ((b[0] + b[1]) + (b[2] + b[3]))) + (((c[0] + c[1]) + (c[2] + c[3])) + ((d[0] + d[1]) + (d[2] + d[3])));
    return rsqrtf(s * (1.0f / 1024.0f) + 1e-6f);
}

struct EpiSwiGLU {
    static constexpr bool PERM = true, AFTER_DRAIN = false;
    bf16_t* G; const float* rp;
    __device__ __forceinline__ void operator()(const f32x4 (&acc)[2][2][4][2], const Unit& u, int wr, int wc, int fr, int fq) const {
        const int row0 = u.pm * BM + wr * 64 + fr, col0 = u.pn * 128 + wc * 32 + 8 * fq;
#pragma unroll
        for (int ai = 0; ai < 2; ++ai)
#pragma unroll
            for (int m = 0; m < 4; ++m) { const int row = row0 + ai * HALF + m * 16; const float r = rp ? row_rs(rp, row) : 1.0f;
                const f32x4 g0 = silu4(acc[ai][0][m][0] * r) * (acc[ai][1][m][0] * r), g1 = silu4(acc[ai][0][m][1] * r) * (acc[ai][1][m][1] * r);
                *(u32x4*)(G + (size_t)row * 2816 + col0) = pack8(g0, g1); }
    }
};
struct EpiResid {
    static constexpr bool PERM = true, AFTER_DRAIN = false;
    const float* baseP; const float* baseS; float* H; bf16_t* XO; float* rp;
    __device__ __forceinline__ void operator()(const f32x4 (&acc)[2][2][4][2], const Unit& u, int wr, int wc, int fr, int fq) const {
        const int row0 = u.pm * BM + wr * 64 + fr, col0 = u.pn * BM + wc * 32 + 8 * fq;
#pragma unroll
        for (int ai = 0; ai < 2; ++ai)
#pragma unroll
            for (int m = 0; m < 4; ++m) { const int row = row0 + ai * HALF + m * 16;
                const float* bp = (row < 16384 ? baseP + (size_t)row * 1024 : baseS + (size_t)(row - 16384) * 1024) + col0; float ss = 0.f;
#pragma unroll
                for (int bj = 0; bj < 2; ++bj) { const f32x4 x0 = *(const f32x4*)(bp + bj * HALF), x1 = *(const f32x4*)(bp + bj * HALF + 4);
                    const f32x4 h0 = x0 + acc[ai][bj][m][0] * 0.5f, h1 = x1 + acc[ai][bj][m][1] * 0.5f; const size_t o = (size_t)row * 1024 + col0 + bj * HALF;
                    *(f32x4*)(H + o) = h0; *(f32x4*)(H + o + 4) = h1; *(u32x4*)(XO + o) = pack8(h0, h1); ss += dot4(h0) + dot4(h1); }
                ss += __shfl_xor(ss, 16); ss += __shfl_xor(ss, 32);
                if (fq == 0) rp[((size_t)u.pn * 16896 + row) * 4 + wc] = ss; }
    }
};
struct EpiQKV {
    static constexpr bool PERM = true, AFTER_DRAIN = false;
    bf16_t *QK, *V, *RG; float* AL; const float* rp; const float* b_alpha; const float* cosT; const float* sinT;
    __device__ __forceinline__ void operator()(const f32x4 (&acc)[2][2][4][2], const Unit& u, int wr, int wc, int fr, int fq) const {
        const int pn = u.pn; int mode = 0, cb = 0; bf16_t* dst = QK; float sc = 1.0f;
        if (pn == 0) { sc = 0.125f; } else if (pn == 1) { cb = 256; } else if (pn <= 3) { dst = V; cb = (pn - 2) * 256; } else if (pn <= 5) { mode = 1; dst = RG; cb = (pn - 4) * 256; }
        else if (pn == 6) { mode = 2; cb = 512; } else if (pn == 7) { mode = 2; cb = 768; sc = 0.125f; } else if (pn <= 9) { dst = V; cb = 512 + (pn - 8) * 256; }
        else if (pn <= 11) { mode = 1; dst = RG; cb = 512 + (pn - 10) * 256; } else { mode = 3; }
        const int row0 = u.pm * BM + wr * 64 + fr;
#pragma unroll
        for (int ai = 0; ai < 2; ++ai)
#pragma unroll
            for (int m = 0; m < 4; ++m) { const int row = row0 + ai * HALF + m * 16; const float r = row_rs(rp, row) * sc;
                if (mode <= 1) {
#pragma unroll
                    for (int bj = 0; bj < 2; ++bj) { f32x4 v0 = acc[ai][bj][m][0] * r, v1 = acc[ai][bj][m][1] * r; if (mode == 1) { v0 = silu4(v0); v1 = silu4(v1); }
                        *(u32x4*)(dst + (size_t)row * 1024 + cb + bj * HALF + wc * 32 + 8 * fq) = pack8(v0, v1); }
                } else if (mode == 2) {
                    const int pidx = row < 16384 ? (row & 2047) : 2048 + (row & 3);
                    const f32x4 c0 = *(const f32x4*)(cosT + pidx * 32 + 8 * fq), c1 = *(const f32x4*)(cosT + pidx * 32 + 8 * fq + 4), s0 = *(const f32x4*)(sinT + pidx * 32 + 8 * fq), s1 = *(const f32x4*)(sinT + pidx * 32 + 8 * fq + 4);
                    const f32x4 x10 = acc[ai][0][m][0] * r, x11 = acc[ai][0][m][1] * r, x20 = acc[ai][1][m][0] * r, x21 = acc[ai][1][m][1] * r;
                    bf16_t* o = dst + (size_t)row * 1024 + cb + wc * 64 + 8 * fq;
                    *(u32x4*)(o) = pack8(x10 * c0 - x20 * s0, x11 * c1 - x21 * s1); *(u32x4*)(o + 32) = pack8(x10 * s0 + x20 * c0, x11 * s1 + x21 * c1);
                }
            }
        if (mode == 3) {
            const bool prompt = u.pm < 64;
#pragma unroll
            for (int ai = 0; ai < 2; ++ai) { float rr[4];
#pragma unroll
                for (int m = 0; m < 4; ++m) rr[m] = row_rs(rp, row0 + ai * HALF + m * 16);
#pragma unroll
                for (int bj = 0; bj < 2; ++bj)
#pragma unroll
                    for (int n = 0; n < 2; ++n) { const int col = bj * HALF + wc * 32 + 8 * fq + 4 * n; const f32x4 bb = *(const f32x4*)(b_alpha + col); f32x4 y[4];
#pragma unroll
                        for (int m = 0; m < 4; ++m) { const f32x4 x = acc[ai][bj][m][n] * rr[m] + bb;
#pragma unroll
                            for (int e = 0; e < 4; ++e) y[m][e] = (fminf(x[e], 0.f) - __logf(1.0f + __expf(-fabsf(x[e])))) * 0.0625f; }
                        if (prompt) { f32x4 run = (f32x4){0.f, 0.f, 0.f, 0.f};
#pragma unroll
                            for (int m = 0; m < 4; ++m) {
#pragma unroll
                                for (int e = 0; e < 4; ++e) { float v = y[m][e];
                                    v += __int_as_float(__builtin_amdgcn_update_dpp(0, __float_as_int(v), 0x111, 0xF, 0xF, true));
                                    v += __int_as_float(__builtin_amdgcn_update_dpp(0, __float_as_int(v), 0x112, 0xF, 0xF, true));
                                    v += __int_as_float(__builtin_amdgcn_update_dpp(0, __float_as_int(v), 0x114, 0xF, 0xF, true));
                                    v += __int_as_float(__builtin_amdgcn_update_dpp(0, __float_as_int(v), 0x118, 0xF, 0xF, true));
                                    v += run[e]; y[m][e] = v; run[e] = __shfl(v, fq * 16 + 15); } } }
#pragma unroll
                        for (int m = 0; m < 4; ++m) *(f32x4*)(AL + (size_t)(row0 + ai * HALF + m * 16) * 256 + col) = y[m]; } }
        }
    }
};
struct EpiSig {
    static constexpr bool PERM = true, AFTER_DRAIN = false;
    bf16_t* S; const float* rp;
    __device__ __forceinline__ void operator()(const f32x4 (&acc)[2][2][4][2], const Unit& u, int wr, int wc, int fr, int fq) const {
        const int row0 = u.pm * BM + wr * 64 + fr, col0 = u.pn * BM + wc * 32 + 8 * fq;
#pragma unroll
        for (int ai = 0; ai < 2; ++ai)
#pragma unroll
            for (int m = 0; m < 4; ++m) { const int row = row0 + ai * HALF + m * 16; const float r = row_rs(rp, row);
#pragma unroll
                for (int bj = 0; bj < 2; ++bj) *(u32x4*)(S + (size_t)row * 1024 + col0 + bj * HALF) = pack8(sigm4(acc[ai][bj][m][0] * r), sigm4(acc[ai][bj][m][1] * r)); }
    }
};
struct EpiGateAcc {
    static constexpr bool PERM = true, AFTER_DRAIN = false;
    const bf16_t* S; float* H; bf16_t* XO; float* rp;
    __device__ __forceinline__ void operator()(const f32x4 (&acc)[2][2][4][2], const Unit& u, int wr, int wc, int fr, int fq) const {
        const int row0 = u.pm * BM + wr * 64 + fr, col0 = u.pn * BM + wc * 32 + 8 * fq;
#pragma unroll
        for (int ai = 0; ai < 2; ++ai)
#pragma unroll
            for (int m = 0; m < 4; ++m) { const int row = row0 + ai * HALF + m * 16; float ss = 0.f;
#pragma unroll
                for (int bj = 0; bj < 2; ++bj) { const size_t o = (size_t)row * 1024 + col0 + bj * HALF; f32x4 s0, s1; unpack8(*(const u32x4*)(S + o), s0, s1);
                    const f32x4 h0 = *(const f32x4*)(H + o) + s0 * acc[ai][bj][m][0], h1 = *(const f32x4*)(H + o + 4) + s1 * acc[ai][bj][m][1];
                    *(f32x4*)(H + o) = h0; *(f32x4*)(H + o + 4) = h1; if (XO) *(u32x4*)(XO + o) = pack8(h0, h1); ss += dot4(h0) + dot4(h1); }
                if (rp) { ss += __shfl_xor(ss, 16); ss += __shfl_xor(ss, 32); if (fq == 0) rp[((size_t)u.pn * 16896 + row) * 4 + wc] = ss; } }
    }
};

template <class Epi, class Sched, bool ALIGN_EPI = false, bool SP2 = false>
__device__ __forceinline__ void gemm_phase(PG8_LAS unsigned char* lds, const Gemm g, const Sched& S, const Epi& E) {
    const int tid = threadIdx.x, wid = __builtin_amdgcn_readfirstlane(tid >> 6), lane = tid & 63, wr = wid >> 2, wc = wid & 3, fr = lane & 15, fq = lane >> 4;
    const int K = g.K, nt = K / BK;
    unsigned voffA[2], voffB[2];
#pragma unroll
    for (int i = 0; i < 2; ++i) { int R, C; stage_rc(tid * 16 + i * 8192, R, C); const int Rb = Epi::PERM ? ((R & ~31) + perm32(R & 31)) : R;
        voffA[i] = (unsigned)(R * g.lda + C) * 2u; voffB[i] = (unsigned)(Rb * g.ldb + C) * 2u; }
    const size_t kstep = (size_t)(BK * 2);
    const size_t hstepA = (size_t)HALF * g.lda * 2, hstepB = (size_t)HALF * g.ldb * 2;
    const size_t tstepA = 2 * hstepA, tstepB = 2 * hstepB;
    const unsigned ldsw = (unsigned)wid * 1024u;
    const int aoff = lds_byte(wr * 64 + fr, fq * 8), boff = lds_byte(wc * 32 + fr, fq * 8);
#define PG8_SA(b, h) (((b) * 2 + (h)) * HTB)
#define PG8_SB(b, h) ((4 + (b) * 2 + (h)) * HTB)
#define PG8_STAGE(bufoff, gbase, voff) do { _Pragma("unroll") for (int _i = 0; _i < 2; ++_i) \
        __builtin_amdgcn_global_load_lds((const unsigned*)((const char*)(gbase) + (voff)[_i]), (PG8_LAS unsigned*)(lds + (bufoff) + ldsw + _i * 8192), 16, 0, 0); } while (0)
#define PG8_LDA(dst, b, h) do { _Pragma("unroll") for (int m = 0; m < 4; ++m) _Pragma("unroll") for (int k = 0; k < 2; ++k) dst[m][k] = *(const PG8_LAS bf16x8*)(lds + PG8_SA(b, h) + aoff + m * 2048 + k * 1024); } while (0)
#define PG8_LDB(dst, b, h) do { _Pragma("unroll") for (int n = 0; n < 2; ++n) _Pragma("unroll") for (int k = 0; k < 2; ++k) dst[n][k] = *(const PG8_LAS bf16x8*)(lds + PG8_SB(b, h) + boff + n * 2048 + k * 1024); } while (0)
#define PG8_MMA(ai, bj, At, Bt) do { __builtin_amdgcn_s_setprio(1); _Pragma("unroll") for (int m = 0; m < 4; ++m) _Pragma("unroll") for (int n = 0; n < 2; ++n) _Pragma("unroll") for (int k = 0; k < 2; ++k) \
        acc[ai][bj][m][n] = __builtin_amdgcn_mfma_f32_16x16x32_bf16(Bt[n][k], At[m][k], acc[ai][bj][m][n], 0, 0, 0); __builtin_amdgcn_s_setprio(0); } while (0)
#define PG8_WAIT_V(n) asm volatile("s_waitcnt vmcnt(" #n ")" ::: "memory")
#define PG8_WAIT_L(n) asm volatile("s_waitcnt lgkmcnt(" #n ")" ::: "memory")
#define PG8_BAR __builtin_amdgcn_s_barrier()
#define PG8_SCHED __builtin_amdgcn_sched_barrier(0)
    Unit cur, nxt; int ui = 0;
    if (!S.next(0, cur)) return;
    f32x4 acc[2][2][4][2];
#pragma unroll
    for (int a = 0; a < 2; ++a)
#pragma unroll
        for (int b = 0; b < 2; ++b)
#pragma unroll
            for (int m = 0; m < 4; ++m)
#pragma unroll
                for (int n = 0; n < 2; ++n) acc[a][b][m][n] = (f32x4){0.f, 0.f, 0.f, 0.f};
    bf16x8 At[4][2], B0[2][2], B1[2][2];
    const char* cA = (const char*)g.A + (size_t)cur.pm * tstepA; const char* cB = (const char*)g.Bt + (size_t)cur.pn * tstepB;
    S.a_ready(cur);
    if constexpr (SP2) {
        PG8_STAGE(PG8_SB(0, 0), cB, voffB); PG8_STAGE(PG8_SB(0, 1), cB + hstepB, voffB); PG8_STAGE(PG8_SA(0, 0), cA, voffA); PG8_STAGE(PG8_SA(0, 1), cA + hstepA, voffA);
        if (wr == 1) PG8_BAR;
        PG8_WAIT_V(2); PG8_BAR;
        PG8_STAGE(PG8_SB(1, 0), cB + kstep, voffB); PG8_STAGE(PG8_SA(1, 0), cA + kstep, voffA); PG8_STAGE(PG8_SB(1, 1), cB + hstepB + kstep, voffB);
        PG8_WAIT_V(6); PG8_BAR;
    } else {
        PG8_STAGE(PG8_SB(0, 0), cB, voffB); PG8_STAGE(PG8_SA(0, 0), cA, voffA); PG8_STAGE(PG8_SB(0, 1), cB + hstepB, voffB); PG8_STAGE(PG8_SA(0, 1), cA + hstepA, voffA);
        if (wr == 1) PG8_BAR;
        PG8_WAIT_V(4); PG8_BAR;
        PG8_STAGE(PG8_SB(1, 0), cB + kstep, voffB); PG8_STAGE(PG8_SA(1, 0), cA + kstep, voffA); PG8_STAGE(PG8_SB(1, 1), cB + hstepB + kstep, voffB);
        PG8_WAIT_V(6); PG8_BAR;
    }
    for (;;) {
        const bool has_next = S.next(ui + 1, nxt);
        const char* nA = has_next ? (const char*)g.A + (size_t)nxt.pm * tstepA : cA; const char* nB = has_next ? (const char*)g.Bt + (size_t)nxt.pn * tstepB : cB;
        for (int t = 0; t < nt; t += 2) {
            const bool last = (t == nt - 2);
            const char* a1 = cA + (size_t)(t + 1) * kstep;
            const char* a2 = last ? nA : cA + (size_t)(t + 2) * kstep; const char* b2 = last ? nB : cB + (size_t)(t + 2) * kstep;
            const char* a3 = a2 + kstep; const char* b3 = b2 + kstep;
            if (last && has_next) S.a_ready(nxt);
            if constexpr (SP2) {
            PG8_LDB(B0, 0, 0); PG8_LDB(B1, 0, 1); PG8_SCHED; PG8_LDA(At, 0, 0); PG8_STAGE(PG8_SA(1, 1), a1 + hstepA, voffA);
            PG8_WAIT_V(8); PG8_WAIT_L(0); PG8_BAR; PG8_MMA(0, 0, At, B0); PG8_MMA(0, 1, At, B1); PG8_BAR; PG8_SCHED;
            PG8_LDA(At, 0, 1); PG8_STAGE(PG8_SB(0, 0), b2, voffB); PG8_STAGE(PG8_SB(0, 1), b2 + hstepB, voffB); PG8_STAGE(PG8_SA(0, 0), a2, voffA);
            PG8_WAIT_V(8); PG8_WAIT_L(0); PG8_BAR; PG8_MMA(1, 0, At, B0); PG8_MMA(1, 1, At, B1); PG8_BAR; PG8_SCHED;
            PG8_LDB(B0, 1, 0); PG8_LDB(B1, 1, 1); PG8_SCHED; PG8_LDA(At, 1, 0); PG8_STAGE(PG8_SA(0, 1), a2 + hstepA, voffA);
            PG8_WAIT_V(8); PG8_WAIT_L(0); PG8_BAR; PG8_MMA(0, 0, At, B0); PG8_MMA(0, 1, At, B1); PG8_BAR; PG8_SCHED;
            PG8_LDA(At, 1, 1); PG8_STAGE(PG8_SB(1, 0), b3, voffB); PG8_STAGE(PG8_SB(1, 1), b3 + hstepB, voffB); PG8_STAGE(PG8_SA(1, 0), a3, voffA);
            PG8_WAIT_V(8); PG8_WAIT_L(0); PG8_BAR; PG8_MMA(1, 0, At, B0); PG8_MMA(1, 1, At, B1); PG8_BAR; PG8_SCHED;
            } else {
            PG8_LDB(B0, 0, 0); PG8_SCHED; PG8_LDA(At, 0, 0); PG8_STAGE(PG8_SA(1, 1), a1 + hstepA, voffA);
            PG8_WAIT_L(8); PG8_BAR; PG8_WAIT_L(0); PG8_MMA(0, 0, At, B0); PG8_BAR; PG8_SCHED;
            PG8_LDB(B1, 0, 1); PG8_STAGE(PG8_SB(0, 0), b2, voffB);
            PG8_BAR; PG8_WAIT_L(0); PG8_MMA(0, 1, At, B1); PG8_BAR;
            PG8_LDA(At, 0, 1); PG8_STAGE(PG8_SA(0, 0), a2, voffA);
            PG8_BAR; PG8_WAIT_L(0); PG8_MMA(1, 0, At, B0); PG8_BAR; PG8_SCHED;
            PG8_STAGE(PG8_SB(0, 1), b2 + hstepB, voffB);
            PG8_WAIT_V(6); PG8_BAR; PG8_MMA(1, 1, At, B1); PG8_BAR;
            PG8_LDB(B0, 1, 0); PG8_SCHED; PG8_LDA(At, 1, 0); PG8_STAGE(PG8_SA(0, 1), a2 + hstepA, voffA);
            PG8_WAIT_L(8); PG8_BAR; PG8_WAIT_L(0); PG8_MMA(0, 0, At, B0); PG8_BAR; PG8_SCHED;
            PG8_LDB(B1, 1, 1); PG8_STAGE(PG8_SB(1, 0), b3, voffB);
            PG8_BAR; PG8_WAIT_L(0); PG8_MMA(0, 1, At, B1); PG8_BAR;
            PG8_LDA(At, 1, 1); PG8_STAGE(PG8_SA(1, 0), a3, voffA);
            PG8_BAR; PG8_WAIT_L(0); PG8_MMA(1, 0, At, B0); PG8_BAR; PG8_SCHED;
            PG8_STAGE(PG8_SB(1, 1), b3 + hstepB, voffB);
            PG8_WAIT_V(6); PG8_BAR; PG8_MMA(1, 1, At, B1); PG8_BAR;
            }
        }
        if constexpr (ALIGN_EPI) { if (wr == 0) PG8_BAR; }
        if constexpr (!Epi::AFTER_DRAIN) { E(acc, cur, wr, wc, fr, fq); S.done(cur); }
        if (!has_next) break;
#pragma unroll
        for (int a = 0; a < 2; ++a)
#pragma unroll
            for (int b = 0; b < 2; ++b)
#pragma unroll
                for (int m = 0; m < 4; ++m)
#pragma unroll
                    for (int n = 0; n < 2; ++n) acc[a][b][m][n] = (f32x4){0.f, 0.f, 0.f, 0.f};
        cur = nxt; cA = nA; cB = nB; ++ui;
        if constexpr (ALIGN_EPI) { if (wr == 1) PG8_BAR; }
    }
    PG8_WAIT_V(0);
    if constexpr (!ALIGN_EPI) { if (wr == 0) PG8_BAR; }
    PG8_BAR;
    if constexpr (Epi::AFTER_DRAIN) { E.fused(acc, cur, wr, wc, fr, fq, lds, wid, lane); S.done(cur); }
#undef PG8_SA
#undef PG8_SB
#undef PG8_STAGE
#undef PG8_LDA
#undef PG8_LDB
#undef PG8_MMA
#undef PG8_WAIT_V
#undef PG8_WAIT_L
#undef PG8_BAR
#undef PG8_SCHED
}
}

constexpr int NWAVES = 8;
constexpr size_t MiB = 1u << 20, HMiB = 1u << 19;
constexpr size_t WS_W1T = 1 * MiB, WS_W1OT = 12 * MiB, WS_WQKVT = 17 * MiB + HMiB, WS_WGAT = 24 * MiB, WS_WGRT = 26 * MiB, WS_WOT = 28 * MiB, WS_W2T = 30 * MiB, WS_W2OT = 41 * MiB,
                 WS_WPGT = 46 * MiB + HMiB, WS_WPPT = 48 * MiB + HMiB;
constexpr size_t WS_XN = 49 * MiB, WS_XN2 = 82 * MiB, WS_QK = 115 * MiB, WS_V = 148 * MiB, WS_RG = 181 * MiB, WS_AL = 214 * MiB, WS_G = 115 * MiB;
constexpr size_t WS_RP1 = 230 * MiB + HMiB, WS_RP2 = WS_RP1 + MiB + MiB / 4, WS_RP3 = WS_RP2 + MiB + MiB / 4, WS_COS = WS_RP3 + MiB + MiB / 4, WS_SIN = WS_COS + HMiB, WS_RT = WS_SIN + 294912, WS_SL = 82 * MiB, WS_LAMB = 244 * MiB, WS_PBF = WS_SIN + HMiB, WS_END = WS_PBF + 9 * MiB;
static_assert(WS_END <= 256 * MiB, "d_ws map");
static_assert(WS_G + (size_t)MT * FF * 2 <= WS_AL, "G overlays QK|V|RG only");
constexpr size_t OUT_YS = (size_t)MP * DM, OUT_GP = OUT_YS + (size_t)MS * DM, OUT_RP = OUT_GP + 262144, OUT_GS = OUT_RP + 262144, OUT_RS = OUT_GS + 4194304;
constexpr int LDS_BYTES = 147456, RING_BYTES = 131072;

#define LAS __attribute__((address_space(3)))
typedef unsigned short bf16;
typedef unsigned v4u __attribute__((ext_vector_type(4)));
typedef float f32x4 __attribute__((ext_vector_type(4)));
typedef short bf16x8 __attribute__((ext_vector_type(8)));
#define LDS_WAIT() asm volatile("s_waitcnt lgkmcnt(0)" ::: "memory")
__device__ __forceinline__ unsigned f2bf(float f) { unsigned u = __builtin_bit_cast(unsigned, f); return (u + 0x7fffu + ((u >> 16) & 1u)) >> 16; }
__device__ __forceinline__ unsigned pk2(float lo, float hi) { return f2bf(lo) | (f2bf(hi) << 16); }
__device__ __forceinline__ float bf2f(unsigned short v) { return __uint_as_float((unsigned)v << 16); }
__device__ __forceinline__ float wave_sum(float v) {
#pragma unroll
    for (int o = 1; o < 64; o <<= 1) v += __shfl_xor(v, o);
    return v;
}
static __device__ const float ROPE_FREQ[32] = {1.000000000e+00f, 7.498942614e-01f, 5.623413324e-01f, 4.216965139e-01f, 3.162277639e-01f, 2.371373773e-01f, 1.778279394e-01f, 1.333521307e-01f, 1.000000015e-01f, 7.498941571e-02f, 5.623413250e-02f, 4.216965288e-02f, 3.162277490e-02f, 2.371373773e-02f, 1.778279431e-02f, 1.333521493e-02f, 9.999999776e-03f, 7.498941850e-03f, 5.623413250e-03f, 4.216964822e-03f, 3.162277630e-03f, 2.371373586e-03f, 1.778279431e-03f, 1.333521446e-03f, 1.000000047e-03f, 7.498942432e-04f, 5.623413017e-04f, 4.216965172e-04f, 3.162277571e-04f, 2.371373703e-04f, 1.778279402e-04f, 1.333521504e-04f};
__device__ __forceinline__ float ret_lg(int h) { return h == 0 ? -0.0317486983145803f : h == 1 ? -0.015748356968139168f : h == 2 ? -0.007843177461025893f : -0.003913899321136329f; }

struct Args { const float* in[23]; float* out; unsigned char* ws; int ph_lo, ph_hi; };

__device__ __forceinline__ void p0_item(const float* W, int N, int k0, int n0, bf16* WT, int K, int drow0, const float* sc, LAS float* scr, int lane) {
#pragma unroll 8
    for (int i = 0; i < 32; ++i) { const int kk = 2 * i + (lane >> 5); float v = W[(size_t)(k0 + kk) * N + n0 + (lane & 31)]; if (sc) v *= sc[k0 + kk]; scr[kk * 33 + (lane & 31)] = v; }
    LDS_WAIT(); asm volatile("" ::: "memory");
    const int c = lane & 7;
#pragma unroll
    for (int j = 0; j < 4; ++j) { const int n = (lane >> 3) + 8 * j; const LAS float* s = scr + (8 * c) * 33 + n;
        v4u o; o.x = pk2(s[0 * 33], s[1 * 33]); o.y = pk2(s[2 * 33], s[3 * 33]); o.z = pk2(s[4 * 33], s[5 * 33]); o.w = pk2(s[6 * 33], s[7 * 33]);
        *(v4u*)(WT + (size_t)(drow0 + n) * K + k0 + 8 * c) = o; }
    LDS_WAIT(); asm volatile("" ::: "memory");
}
__device__ __forceinline__ void p0_ffn_in(const float* W, bf16* WT, const float* sc, int r, LAS float* scr, int lane) {
    const int kb = r / 176, nb = r % 176, n0 = nb * 32, which = n0 / 2816, hid = n0 % 2816;
    p0_item(W, 5632, kb * 64, n0, WT, 1024, (hid / 128) * 256 + which * 128 + (hid % 128), sc, scr, lane);
}
__device__ __forceinline__ void p0_plain(const float* W, int K, int N, bf16* WT, const float* sc, int r, LAS float* scr, int lane) {
    const int nblk = N / 32, kb = r / nblk, nb = r % nblk;
    p0_item(W, N, kb * 64, nb * 32, WT, K, nb * 32, sc, scr, lane);
}
__device__ __forceinline__ void prologue(const Args& a, LAS unsigned char* lds, int vcu, int G, int tid) {
    const int lane = tid & 63, wave = __builtin_amdgcn_readfirstlane(tid >> 6);
    unsigned char* ws = a.ws;
    LAS float* scr = (LAS float*)(lds + wave * 16384);
    const int gw = vcu * NWAVES + wave, NGW = G * NWAVES;
    const float* w_in = a.in[10];
    constexpr int I_A = 2816, I_B = 1408, I_C = 1536, I_D = 512, I_F = 512, I_J = 128;
    constexpr int NITEMS = 2 * I_A + 2 * I_B + I_C + 2 * I_D + 2 * I_F + I_J;
    for (int it = gw; it < NITEMS; it += NGW) {
        int r = it;
        if (r < I_A) { p0_ffn_in(a.in[7], (bf16*)(ws + WS_W1T), nullptr, r, scr, lane); continue; } r -= I_A;
        if (r < I_A) { p0_ffn_in(a.in[17], (bf16*)(ws + WS_W2T), a.in[16], r, scr, lane); continue; } r -= I_A;
        if (r < I_B) { p0_plain(a.in[8], 2816, 1024, (bf16*)(ws + WS_W1OT), nullptr, r, scr, lane); continue; } r -= I_B;
        if (r < I_B) { p0_plain(a.in[18], 2816, 1024, (bf16*)(ws + WS_W2OT), nullptr, r, scr, lane); continue; } r -= I_B;
        if (r < I_C) { const int kb = r / 96, nb = r % 96, n0 = nb * 32; int d0 = n0;
            if (n0 >= 1536 && n0 < 2048) { const int base = n0 < 1792 ? 1536 : 1792, loc = n0 - base; d0 = base + ((loc & 63) >> 5) * 128 + (loc >> 6) * 32; }
            p0_item(w_in, WIN_N, kb * 64, n0, (bf16*)(ws + WS_WQKVT), 1024, d0, a.in[9], scr, lane); continue; } r -= I_C;
        if (r < I_D) { const int kb = r / 32, nb = r % 32; p0_item(w_in, WIN_N, kb * 64, 3088 + nb * 32, (bf16*)(ws + WS_WGAT), 1024, nb * 32, a.in[9], scr, lane); continue; } r -= I_D;
        if (r < I_D) { const int kb = r / 32, nb = r % 32; p0_item(w_in, WIN_N, kb * 64, 4112 + nb * 32, (bf16*)(ws + WS_WGRT), 1024, nb * 32, a.in[9], scr, lane); continue; } r -= I_D;
        if (r < I_F) { p0_plain(a.in[15], 1024, 1024, (bf16*)(ws + WS_WOT), nullptr, r, scr, lane); continue; } r -= I_F;
        if (r < I_F) { p0_plain(a.in[20], 1024, 1024, (bf16*)(ws + WS_WPGT), a.in[19], r, scr, lane); continue; } r -= I_F;
        p0_plain(a.in[21], 256, 1024, (bf16*)(ws + WS_WPPT), nullptr, r, scr, lane);
    }
    const int gt = vcu * (NWAVES * 64) + tid, NGT = G * NWAVES * 64;
    { const float* wau = a.in[11]; const float* nm = a.in[9]; bf16* WT = (bf16*)(ws + WS_WQKVT);
      for (int task = gt; task < 256 * 128; task += NGT) { const int j = task >> 7, k8 = (task & 127) * 8; float wj[16];
#pragma unroll
          for (int r = 0; r < 16; ++r) wj[r] = wau[r * 256 + j];
          float o[8];
#pragma unroll
          for (int kk = 0; kk < 8; ++kk) { const f32x4* p = (const f32x4*)(w_in + (size_t)(k8 + kk) * WIN_N + 3072); float s = 0.f;
#pragma unroll
              for (int q = 0; q < 4; ++q) { const f32x4 x = p[q]; s += x[0] * wj[4 * q] + x[1] * wj[4 * q + 1] + x[2] * wj[4 * q + 2] + x[3] * wj[4 * q + 3]; }
              o[kk] = s * nm[k8 + kk]; }
          v4u w; w.x = pk2(o[0], o[1]); w.y = pk2(o[2], o[3]); w.z = pk2(o[4], o[5]); w.w = pk2(o[6], o[7]);
          *(v4u*)(WT + (size_t)(3072 + j) * 1024 + k8) = w; } }
    { const f32x4* nw = (const f32x4*)a.in[6] + lane; bf16* XN = (bf16*)(ws + WS_XN);
      for (int m = gw; m < MT; m += NGW) { const float* xrow = m < MP ? a.in[0] + (size_t)m * DM : a.in[1] + (size_t)(m - MP) * DM;
          const f32x4* xr = (const f32x4*)xrow + lane; f32x4 v[4]; float s = 0.f;
#pragma unroll
          for (int j = 0; j < 4; ++j) { v[j] = xr[64 * j]; s += pg8::dot4(v[j]); }
          const float rs = rsqrtf(wave_sum(s) * (1.f / DM) + 1e-6f);
          unsigned long long* o8 = (unsigned long long*)(XN + (size_t)m * DM) + lane;
#pragma unroll
          for (int j = 0; j < 4; ++j) { const f32x4 g = nw[64 * j]; o8[64 * j] = (unsigned long long)pk2(v[j][0] * rs * g[0], v[j][1] * rs * g[1]) | ((unsigned long long)pk2(v[j][2] * rs * g[2], v[j][3] * rs * g[3]) << 32); } } }
    { bf16* PB = (bf16*)(ws + WS_PBF);
      for (int task = gt; task < MT * DPLE / 8; task += NGT) { const size_t e = (size_t)task * 8; const float* src = e < (size_t)MP * DPLE ? a.in[4] + e : a.in[5] + (e - (size_t)MP * DPLE);
          const f32x4 x0 = *(const f32x4*)src, x1 = *(const f32x4*)(src + 4); v4u w; w.x = pk2(x0[0], x0[1]); w.y = pk2(x0[2], x0[3]); w.z = pk2(x1[0], x1[1]); w.w = pk2(x1[2], x1[3]);
          *(v4u*)(PB + e) = w; } }
    { float* cT = (float*)(ws + WS_COS); float* sT = (float*)(ws + WS_SIN);
      for (int task = gt; task < 2052 * 32; task += NGT) { const int pi = task >> 5, d = task & 31, pos = pi < 2048 ? pi : 16384 + (pi - 2048);
          const float ang = (float)pos * ROPE_FREQ[d]; double t = (double)ang * 0.15915494309189535; t -= __builtin_rint(t); const float tf = (float)t;
          cT[task] = __builtin_amdgcn_cosf(tf); sT[task] = __builtin_amdgcn_sinf(tf); }
      if (gt < 256) ((float*)(ws + WS_RT))[gt] = (float)((gt & 63) + 1) * ret_lg(gt >> 6); }
}

constexpr int LQ = 72, LV = 132;
constexpr int S_Q = 0, S_K = 9216, S_KT = 18432, S_V = 27648, S_P = 44544, S_ST = 53760, S_LAM = 72192, S_PART = 72448;
#define MFMA16(a, b, c) __builtin_amdgcn_mfma_f32_16x16x32_bf16(a, b, c, 0, 0, 0)
#define SBAR() do { asm volatile("s_waitcnt lgkmcnt(0)" ::: "memory"); __builtin_amdgcn_s_barrier(); asm volatile("" ::: "memory"); } while (0)
__device__ __forceinline__ void scan_p1(LAS unsigned char* lds, int unit, const Args& a, int tid) {
    const int chain = unit >> 5, ch = unit & 31, b = chain >> 3, hb = chain & 7, br = hb >> 2, h = hb & 3;
    const int lane = tid & 63, w = __builtin_amdgcn_readfirstlane(tid >> 6), fr = lane & 15, fq = lane >> 4;
    unsigned char* ws = a.ws;
    const bf16* QK = (const bf16*)(ws + WS_QK); const bf16* V = (const bf16*)(ws + WS_V); const float* AL = (const float*)(ws + WS_AL); const float* RT = (const float*)(ws + WS_RT);
    bf16* SL = (bf16*)(ws + WS_SL) + (size_t)unit * 8192; float* LB = (float*)(ws + WS_LAMB) + (size_t)unit * 64;
    LAS bf16* sKT = (LAS bf16*)(lds + S_KT); LAS bf16* sV = (LAS bf16*)(lds + S_V);
    const int koff = br * 512 + h * 64 + 256, voff = br * 512 + h * 128, bstr = br ? 1 : 256;
    const size_t row0 = (size_t)b * 2048 + (size_t)ch * 64; const float* bp = br ? RT + h * 64 : AL + row0 * 256 + h * 64 + lane;
    unsigned short pk[8]; float pb[8]; v4u pv[2];
#pragma unroll
    for (int i = 0; i < 8; ++i) { pk[i] = QK[(row0 + w * 8 + i) * 1024 + koff + lane]; pb[i] = bp[(w * 8 + i) * bstr]; }
    const float ptot = bp[63 * bstr];
#pragma unroll
    for (int j = 0; j < 2; ++j) { const int p = tid + j * 512, t = p >> 4, c8 = (p & 15) * 8; pv[j] = *(const v4u*)(V + (row0 + t) * 1024 + voff + c8); }
#pragma unroll
    for (int i = 0; i < 8; ++i) { const int t = w * 8 + i; sKT[lane * LQ + t] = (bf16)f2bf(bf2f(pk[i]) * __expf(ptot - pb[i])); }
    if (w == 0) LB[lane] = __expf(ptot);
#pragma unroll
    for (int j = 0; j < 2; ++j) { const int p = tid + j * 512, t = p >> 4, c8 = (p & 15) * 8; typedef unsigned u32x2 __attribute__((ext_vector_type(2)));
        *(LAS u32x2*)(sV + t * LV + c8) = (u32x2){pv[j].x, pv[j].y}; *(LAS u32x2*)(sV + t * LV + c8 + 4) = (u32x2){pv[j].z, pv[j].w}; }
    SBAR();
    bf16x8 bv[2];
#pragma unroll
    for (int ks = 0; ks < 2; ++ks)
#pragma unroll
        for (int e = 0; e < 8; ++e) bv[ks][e] = (short)sV[(ks * 32 + fq * 8 + e) * LV + w * 16 + fr];
#pragma unroll
    for (int dt = 0; dt < 4; ++dt) { f32x4 u = (f32x4){0.f, 0.f, 0.f, 0.f};
#pragma unroll
        for (int ks = 0; ks < 2; ++ks) { const bf16x8 y = *(const LAS bf16x8*)(sKT + (dt * 16 + fr) * LQ + ks * 32 + fq * 8); u = MFMA16(bv[ks], y, u); }
#pragma unroll
        for (int r = 0; r < 4; ++r) SL[(w * 16 + 4 * fq + r) * 64 + dt * 16 + fr] = (bf16)f2bf(u[r]); }
    SBAR();
}
__device__ __forceinline__ void scan_p2(const Args& a, int task) {
    const int chain = task >> 10, c = (task >> 3) & 127, dg = task & 7, b = chain >> 3, hb = chain & 7, br = hb >> 2, h = hb & 3;
    unsigned char* ws = a.ws;
    bf16* SL = (bf16*)(ws + WS_SL) + (size_t)chain * 32 * 8192 + c * 64 + dg * 8; const float* LB = (const float*)(ws + WS_LAMB) + (size_t)chain * 32 * 64 + dg * 8;
    f32x4 s0 = (f32x4){0.f, 0.f, 0.f, 0.f}, s1 = s0;
#pragma unroll 8
    for (int ch = 0; ch < 32; ++ch) { const v4u uu = *(const v4u*)(SL + (size_t)ch * 8192); const f32x4 l0 = *(const f32x4*)(LB + ch * 64), l1 = *(const f32x4*)(LB + ch * 64 + 4);
        f32x4 u0, u1; pg8::unpack8(uu, u0, u1);
        *(v4u*)(SL + (size_t)ch * 8192) = pg8::pack8(s0, s1);
        s0 = l0 * s0 + u0; s1 = l1 * s1 + u1; }
    float* so = a.out + (br ? OUT_RP : OUT_GP) + (size_t)(b * 4 + h) * 8192 + (size_t)(dg * 8) * 128 + c;
#pragma unroll
    for (int e = 0; e < 4; ++e) { so[e * 128] = s0[e]; so[(e + 4) * 128] = s1[e]; }
}
__device__ __forceinline__ void scan_p3(LAS unsigned char* lds, int unit, const Args& a, int tid) {
    const int chain = unit >> 5, ch = unit & 31, b = chain >> 3, hb = chain & 7, br = hb >> 2, h = hb & 3;
    const int lane = tid & 63, w = __builtin_amdgcn_readfirstlane(tid >> 6), fr = lane & 15, fq = lane >> 4;
    unsigned char* ws = a.ws;
    const bf16* QK = (const bf16*)(ws + WS_QK); const bf16* V = (const bf16*)(ws + WS_V); bf16* RG = (bf16*)(ws + WS_RG); const float* AL = (const float*)(ws + WS_AL); const float* RT = (const float*)(ws + WS_RT);
    const bf16* SL = (const bf16*)(ws + WS_SL) + (size_t)unit * 8192;
    LAS bf16* sQ = (LAS bf16*)(lds + S_Q); LAS bf16* sK = (LAS bf16*)(lds + S_K); LAS bf16* sV = (LAS bf16*)(lds + S_V); LAS bf16* sP = (LAS bf16*)(lds + S_P); LAS float* sPART = (LAS float*)(lds + S_PART);
    const int qoff = br * 512 + h * 64, koff = qoff + 256, voff = br * 512 + h * 128, bstr = br ? 1 : 256;
    const float gnw = (br ? a.in[14] : a.in[13])[h * 128 + w * 16 + fr];
    const size_t row0 = (size_t)b * 2048 + (size_t)ch * 64; const float* bp = br ? RT + h * 64 : AL + row0 * 256 + h * 64 + lane;
    unsigned short pq[8], pk[8], pgt[16]; float pb[8]; v4u pv[2]; bf16x8 bs[2];
#pragma unroll
    for (int i = 0; i < 8; ++i) { const size_t row = row0 + w * 8 + i; pq[i] = QK[row * 1024 + qoff + lane]; pk[i] = QK[row * 1024 + koff + lane]; pb[i] = bp[(w * 8 + i) * bstr]; }
#pragma unroll
    for (int j = 0; j < 2; ++j) { const int p = tid + j * 512, t = p >> 4, c8 = (p & 15) * 8; pv[j] = *(const v4u*)(V + (row0 + t) * 1024 + voff + c8); }
#pragma unroll
    for (int ks = 0; ks < 2; ++ks) bs[ks] = *(const bf16x8*)(SL + (w * 16 + fr) * 64 + ks * 32 + fq * 8);
#pragma unroll
    for (int q = 0; q < 16; ++q) pgt[q] = RG[(row0 + (q >> 2) * 16 + 4 * fq + (q & 3)) * 1024 + voff + w * 16 + fr];
#pragma unroll
    for (int i = 0; i < 8; ++i) { const int t = w * 8 + i; const float bb = pb[i];
        sQ[t * LQ + lane] = (bf16)f2bf(bf2f(pq[i]) * __expf(bb)); sK[t * LQ + lane] = (bf16)f2bf(bf2f(pk[i]) * __expf(-bb)); }
#pragma unroll
    for (int j = 0; j < 2; ++j) { const int p = tid + j * 512, t = p >> 4, c8 = (p & 15) * 8; typedef unsigned u32x2 __attribute__((ext_vector_type(2)));
        *(LAS u32x2*)(sV + t * LV + c8) = (u32x2){pv[j].x, pv[j].y}; *(LAS u32x2*)(sV + t * LV + c8 + 4) = (u32x2){pv[j].z, pv[j].w}; }
    SBAR();
    { const int it = w >> 1;
#pragma unroll
      for (int jj = 0; jj < 2; ++jj) { const int jt = (w & 1) * 2 + jj; f32x4 p = (f32x4){0.f, 0.f, 0.f, 0.f};
          if (jt <= it) {
#pragma unroll
              for (int ks = 0; ks < 2; ++ks) { const bf16x8 x = *(const LAS bf16x8*)(sQ + (it * 16 + fr) * LQ + ks * 32 + fq * 8), y = *(const LAS bf16x8*)(sK + (jt * 16 + fr) * LQ + ks * 32 + fq * 8); p = MFMA16(x, y, p); } }
#pragma unroll
          for (int r = 0; r < 4; ++r) { const int gi = it * 16 + 4 * fq + r, gj = jt * 16 + fr; sP[gi * LQ + gj] = (bf16)f2bf(gj <= gi ? p[r] : 0.f); } } }
    bf16x8 bv[2];
#pragma unroll
    for (int ks = 0; ks < 2; ++ks)
#pragma unroll
        for (int e = 0; e < 8; ++e) bv[ks][e] = (short)sV[(ks * 32 + fq * 8 + e) * LV + w * 16 + fr];
    SBAR();
    f32x4 accO[4];
#pragma unroll
    for (int it = 0; it < 4; ++it) { f32x4 o = (f32x4){0.f, 0.f, 0.f, 0.f};
#pragma unroll
        for (int ks = 0; ks < 2; ++ks) { const bf16x8 x = *(const LAS bf16x8*)(sP + (it * 16 + fr) * LQ + ks * 32 + fq * 8); o = MFMA16(x, bv[ks], o); }
#pragma unroll
        for (int ks = 0; ks < 2; ++ks) { const bf16x8 x = *(const LAS bf16x8*)(sQ + (it * 16 + fr) * LQ + ks * 32 + fq * 8); o = MFMA16(x, bs[ks], o); }
        accO[it] = o;
#pragma unroll
        for (int r = 0; r < 4; ++r) { float s = o[r] * o[r]; s += __shfl_xor(s, 1); s += __shfl_xor(s, 2); s += __shfl_xor(s, 4); s += __shfl_xor(s, 8); if (fr == 0) sPART[(it * 16 + 4 * fq + r) * 8 + w] = s; } }
    SBAR();
#pragma unroll
    for (int it = 0; it < 4; ++it)
#pragma unroll
        for (int r = 0; r < 4; ++r) { const int i = it * 16 + 4 * fq + r; const f32x4 p0 = *(const LAS f32x4*)(sPART + i * 8), p1 = *(const LAS f32x4*)(sPART + i * 8 + 4);
            const float ss = ((p0[0] + p0[1]) + (p0[2] + p0[3])) + ((p1[0] + p1[1]) + (p1[2] + p1[3])); const float rs = rsqrtf(ss * (1.0f / 128.0f) + 1e-6f);
            RG[(row0 + i) * 1024 + voff + w * 16 + fr] = (bf16)f2bf(accO[it][r] * rs * gnw * bf2f(pgt[it * 4 + r])); }
    SBAR();
}
__device__ __forceinline__ void scan_sample(LAS unsigned char* lds, int item, const Args& a, int tid) {
    const int bs = item >> 3, hb = item & 7, br = hb >> 2, h = hb & 3;
    const int lane = tid & 63, w = __builtin_amdgcn_readfirstlane(tid >> 6);
    unsigned char* ws = a.ws;
    const bf16* QK = (const bf16*)(ws + WS_QK); const bf16* Vb = (const bf16*)(ws + WS_V); bf16* RG = (bf16*)(ws + WS_RG); const float* AL = (const float*)(ws + WS_AL);
    LAS float* L = (LAS float*)lds;
    LAS float* sQ = L; LAS float* sK = L + 256; LAS float* sG = L + 512; LAS float* sV = L + 768; LAS float* sGT = L + 1280; LAS float* sQT = L + 1792; LAS float* sKH = L + 2048;
    LAS float* sLAM = L + 2304; LAS float* sPP = L + 2368; LAS float* sOP = L + 2384; LAS float* sSS = L + 4432;
    const size_t row0 = (size_t)MP + (size_t)bs * 4;
    const int qoff = br * 512 + h * 64, koff = qoff + 256, voff = br * 512 + h * 128;
    const float* S0 = (br ? a.in[3] : a.in[2]) + (size_t)(bs * 4 + h) * 8192;
    float* S1 = a.out + (br ? OUT_RS : OUT_GS) + (size_t)(bs * 4 + h) * 8192;
    const float* gn = (br ? a.in[14] : a.in[13]) + h * 128;
    const int c = tid & 127, dq = tid >> 7;
    float s0[16];
#pragma unroll
    for (int dd = 0; dd < 16; ++dd) s0[dd] = S0[(dq * 16 + dd) * 128 + c];
    if (tid < 256) { const int t = tid >> 6, d = tid & 63; const size_t row = row0 + t; sQ[t * 64 + d] = bf2f(QK[row * 1024 + qoff + d]); sK[t * 64 + d] = bf2f(QK[row * 1024 + koff + d]); sG[t * 64 + d] = br ? ret_lg(h) : AL[row * 256 + h * 64 + d]; }
    { const int t = tid >> 7; sV[t * 128 + c] = bf2f(Vb[(row0 + t) * 1024 + voff + c]); sGT[t * 128 + c] = bf2f(RG[(row0 + t) * 1024 + voff + c]); }
    const float gnc = gn[c];
    SBAR();
    if (tid < 64) { const int d = tid; float bc[4]; float run = 0.f;
#pragma unroll
        for (int t = 0; t < 4; ++t) { run += sG[t * 64 + d]; bc[t] = run; }
#pragma unroll
        for (int t = 0; t < 4; ++t) { sQT[t * 64 + d] = sQ[t * 64 + d] * __expf(bc[t]); sKH[t * 64 + d] = sK[t * 64 + d] * __expf(bc[3] - bc[t]); }
        sLAM[d] = __expf(bc[3]);
#pragma unroll
        for (int t = 0; t < 4; ++t)
#pragma unroll
            for (int j = 0; j < 4; ++j) if (j <= t) { float p = sQ[t * 64 + d] * sK[j * 64 + d] * __expf(bc[t] - bc[j]); p = wave_sum(p); if (d == 0) sPP[t * 4 + j] = p; } }
    SBAR();
    { float po[4] = {0.f, 0.f, 0.f, 0.f}; float vj[4];
#pragma unroll
      for (int j = 0; j < 4; ++j) vj[j] = sV[j * 128 + c];
#pragma unroll
      for (int dd = 0; dd < 16; ++dd) { const int d = dq * 16 + dd; const float s = s0[dd];
#pragma unroll
          for (int t = 0; t < 4; ++t) po[t] += sQT[t * 64 + d] * s;
          float sn = sLAM[d] * s;
#pragma unroll
          for (int j = 0; j < 4; ++j) sn += sKH[j * 64 + d] * vj[j];
          S1[d * 128 + c] = sn; }
#pragma unroll
      for (int t = 0; t < 4; ++t) sOP[(dq * 4 + t) * 128 + c] = po[t]; }
    SBAR();
    { const int t = tid >> 7; float o = (sOP[(0 * 4 + t) * 128 + c] + sOP[(1 * 4 + t) * 128 + c]) + (sOP[(2 * 4 + t) * 128 + c] + sOP[(3 * 4 + t) * 128 + c]);
#pragma unroll
      for (int j = 0; j < 4; ++j) if (j <= t) o += sPP[t * 4 + j] * sV[j * 128 + c];
      const float ss = wave_sum(o * o); if (lane == 0) sSS[w] = ss;
      SBAR();
      const float rs = rsqrtf((sSS[2 * t] + sSS[2 * t + 1]) * (1.0f / 128.0f) + 1e-6f);
      RG[(row0 + t) * 1024 + voff + c] = (bf16)f2bf(o * rs * gnc * sGT[t * 128 + c]); }
    SBAR();
}

#define XB_TMO      128
#define XB_XCNT(j)  (256  + 64 * (j))
#define XB_XSUB(j)  (1280 + 64 * (j))
#define XB_XGEN(j)  (2304 + 64 * (j))
#define XB_TOP      3328
#define XB_TOPGEN   3392
#define XCD_BAR_WORDS 3456
#define XB_SPIN_CAP (1u << 18)

__device__ __forceinline__ unsigned xb_ld(unsigned* p)              { return __hip_atomic_load(p, __ATOMIC_RELAXED, __HIP_MEMORY_SCOPE_AGENT); }
__device__ __forceinline__ unsigned xb_add(unsigned* p, unsigned v) { return __hip_atomic_fetch_add(p, v, __ATOMIC_RELAXED, __HIP_MEMORY_SCOPE_AGENT); }
__device__ __forceinline__ unsigned xb_xcc_id() { return (unsigned)__builtin_amdgcn_s_getreg((3 << 11) | 20) & 0xFu; }
#define XB_SPIN(cond, bar) do { unsigned _sp = 0; while (cond) { __builtin_amdgcn_s_sleep(1); \
    if ((++_sp & 255u) == 0u) { if (xb_ld(&(bar)[XB_TMO])) break; if (_sp > XB_SPIN_CAP) { atomicAdd(&(bar)[XB_TMO], 1u); break; } } } } while (0)

struct XcdBarrier {
    unsigned* bar; unsigned x;
    volatile LAS unsigned* st;
};

__device__ __forceinline__ XcdBarrier xcd_barrier_post(unsigned* bar, volatile LAS unsigned* st) {
    XcdBarrier b; b.bar = bar; b.x = xb_xcc_id(); b.st = st;
    if (threadIdx.x == 0) (void)xb_add(&bar[XB_XCNT(b.x)], 1u);
    return b;
}
__device__ __forceinline__ void xcd_barrier_complete(unsigned* bar, unsigned x, unsigned& nloc, unsigned& nx) {
    const unsigned G = gridDim.x * gridDim.y * gridDim.z;
    unsigned sum, cnt, mine, sp = 0u;
    for (;;) {
        sum = 0u; cnt = 0u; mine = 0u;
#pragma unroll
        for (unsigned j = 0; j < 16; ++j) { const unsigned c = xb_ld(&bar[XB_XCNT(j)]); sum += c; cnt += (c > 0u) ? 1u : 0u; mine = (j == x) ? c : mine; }
        if (sum == G) break;
        __builtin_amdgcn_s_sleep(1);
        if ((++sp & 255u) == 0u) { if (xb_ld(&bar[XB_TMO])) break; if (sp > XB_SPIN_CAP) { atomicAdd(&bar[XB_TMO], 1u); break; } }
    }
    nloc = mine > 0u ? mine : 1u; nx = cnt > 0u ? cnt : 1u;
}

__device__ __forceinline__ void xcd_barrier(const XcdBarrier& b) {
    asm volatile("s_waitcnt vmcnt(0)" ::: "memory");
    __syncthreads();
    if (threadIdx.x == 0) {
        unsigned* bar = b.bar;
        __builtin_amdgcn_s_waitcnt(0);
        unsigned nloc = b.st[0], nx = b.st[1];
        if (nloc == 0u) { xcd_barrier_complete(bar, b.x, nloc, nx); b.st[0] = nloc; b.st[1] = nx; }
        const unsigned old = xb_add(&bar[XB_XSUB(b.x)], 1u);
        const unsigned gen = old / nloc;
        if (old + 1u == (gen + 1u) * nloc) {
            __builtin_amdgcn_fence(__ATOMIC_RELEASE, "agent");
            asm volatile("s_waitcnt vmcnt(0)" ::: "memory");
            const unsigned og = xb_add(&bar[XB_TOP], 1u);
            const unsigned tg = og / nx;
            if (og + 1u == (tg + 1u) * nx) xb_add(&bar[XB_TOPGEN], 1u);
            else XB_SPIN(xb_ld(&bar[XB_TOPGEN]) == tg, bar);
            __builtin_amdgcn_fence(__ATOMIC_ACQUIRE, "agent");
            xb_add(&bar[XB_XGEN(b.x)], 1u);
            asm volatile("s_waitcnt vmcnt(0)" ::: "memory");
        } else {
            XB_SPIN(xb_ld(&bar[XB_XGEN(b.x)]) == gen, bar);
            __builtin_amdgcn_fence(__ATOMIC_ACQUIRE, "agent");
            asm volatile("s_waitcnt vmcnt(0)" ::: "memory");
        }
    }
    __syncthreads();
}

__global__ void __launch_bounds__(NWAVES * 64, 2) mk_fwd(Args args) {
    extern __shared__ __attribute__((aligned(16))) unsigned char lds_raw[];
    LAS unsigned char* lds = (LAS unsigned char*)lds_raw;
    const int tid = threadIdx.x, lane = tid & 63, wave = __builtin_amdgcn_readfirstlane(tid >> 6);
    const int G = gridDim.x, bx = blockIdx.x, vcu = (G % 8 == 0) ? (bx % 8) * (G / 8) + bx / 8 : bx;
    unsigned char* ws = args.ws;
    const int lo = args.ph_lo, hi = args.ph_hi;
#define IN(k) (lo <= (k) && (k) < hi)
#if MK_SINGLE
    volatile LAS unsigned* MISC = (volatile LAS unsigned*)(lds + RING_BYTES + 320);
    if (tid < 64) ((LAS unsigned*)(lds + RING_BYTES))[tid + 64] = 0u;
    __syncthreads();
    XcdBarrier bar = xcd_barrier_post((unsigned*)ws + 4096, MISC + 8);
    if (hi > 1000) cg::this_grid().sync();
#define SEAM(k) do { if (IN(k) && IN((k) + 1)) xcd_barrier(bar); } while (0)
#else
#define SEAM(k) do { } while (0)
#endif
    bf16* XN = (bf16*)(ws + WS_XN); bf16* XN2 = (bf16*)(ws + WS_XN2); bf16* GB = (bf16*)(ws + WS_G);
    bf16* QK = (bf16*)(ws + WS_QK); bf16* VB = (bf16*)(ws + WS_V); bf16* RG = (bf16*)(ws + WS_RG); float* AL = (float*)(ws + WS_AL);
    float* RP1 = (float*)(ws + WS_RP1); float* RP2 = (float*)(ws + WS_RP2); float* RP3 = (float*)(ws + WS_RP3);
    float* H = args.out;

    if (IN(0)) { prologue(args, lds, vcu, G, tid); } SEAM(0);
    if (IN(1)) {
        pg8::Gemm g{XN, (const bf16*)(ws + WS_W1T), MT, 2 * FF, DM, DM, DM}; pg8::StaticOrder S; S.init(MT, 2 * FF, G, bx);
        pg8::EpiSwiGLU E{GB, nullptr};
        pg8::gemm_phase<pg8::EpiSwiGLU, pg8::StaticOrder, true, true>(lds, g, S, E);
    } SEAM(1);
    if (IN(2)) {
        pg8::Gemm g{GB, (const bf16*)(ws + WS_W1OT), MT, DM, FF, FF, FF}; pg8::StaticOrder S; S.init(MT, DM, G, bx);
        pg8::EpiResid E{args.in[0], args.in[1], H, XN, RP1};
        pg8::gemm_phase<pg8::EpiResid, pg8::StaticOrder, true, true>(lds, g, S, E);
    } SEAM(2);
    if (IN(3)) {
        pg8::Gemm g{XN, (const bf16*)(ws + WS_WQKVT), MT, NQKV, DM, DM, DM}; pg8::StaticOrder S; S.init(MT, NQKV, G, bx);
        pg8::EpiQKV E{QK, VB, RG, AL, RP1, args.in[12], (const float*)(ws + WS_COS), (const float*)(ws + WS_SIN)};
        pg8::gemm_phase<pg8::EpiQKV, pg8::StaticOrder, true, true>(lds, g, S, E);
    } SEAM(3);
    if (IN(4)) {
        for (int u = bx; u < 2048; u += G) scan_p1(lds, u, args, tid);
        xcd_barrier(bar);
        for (int t = bx * (NWAVES * 64) + tid; t < 64 * 1024; t += G * NWAVES * 64) scan_p2(args, t);
        for (int it = bx; it < 1024; it += G) scan_sample(lds, it, args, tid);
        xcd_barrier(bar);
        for (int u = bx; u < 2048; u += G) scan_p3(lds, u, args, tid);
    } SEAM(4);
    if (IN(5)) {
        pg8::StaticOrder S; S.init(MT, DM, G, bx);
        { pg8::Gemm g{XN, (const bf16*)(ws + WS_WGAT), MT, DM, DM, DM, DM}; pg8::EpiSig E{QK, RP1}; pg8::gemm_phase<pg8::EpiSig, pg8::StaticOrder, true, true>(lds, g, S, E); }
        { pg8::Gemm g{XN, (const bf16*)(ws + WS_WGRT), MT, DM, DM, DM, DM}; pg8::EpiSig E{VB, RP1}; pg8::gemm_phase<pg8::EpiSig, pg8::StaticOrder, true, true>(lds, g, S, E); }
        { pg8::Gemm g{RG, (const bf16*)(ws + WS_WOT), MT, DM, 512, DM, DM}; pg8::EpiGateAcc E{QK, H, nullptr, nullptr}; pg8::gemm_phase<pg8::EpiGateAcc, pg8::StaticOrder, true, true>(lds, g, S, E); }
        { pg8::Gemm g{RG + 512, (const bf16*)(ws + WS_WOT) + 512, MT, DM, 512, DM, DM}; pg8::EpiGateAcc E{VB, H, XN2, RP2}; pg8::gemm_phase<pg8::EpiGateAcc, pg8::StaticOrder, true, true>(lds, g, S, E); }
    } SEAM(5);
    if (IN(6)) {
        pg8::Gemm g{XN2, (const bf16*)(ws + WS_W2T), MT, 2 * FF, DM, DM, DM}; pg8::StaticOrder S; S.init(MT, 2 * FF, G, bx);
        pg8::EpiSwiGLU E{GB, RP2};
        pg8::gemm_phase<pg8::EpiSwiGLU, pg8::StaticOrder, true, true>(lds, g, S, E);
    } SEAM(6);
    if (IN(7)) {
        pg8::Gemm g{GB, (const bf16*)(ws + WS_W2OT), MT, DM, FF, FF, FF}; pg8::StaticOrder S; S.init(MT, DM, G, bx);
        pg8::EpiResid E{H, H + (size_t)MP * DM, H, XN, RP3};
        pg8::gemm_phase<pg8::EpiResid, pg8::StaticOrder, true, true>(lds, g, S, E);
    } SEAM(7);
    if (IN(8)) {
        pg8::StaticOrder S; S.init(MT, DM, G, bx);
        { pg8::Gemm g{XN, (const bf16*)(ws + WS_WPGT), MT, DM, DM, DM, DM}; pg8::EpiSig E{QK, RP3}; pg8::gemm_phase<pg8::EpiSig, pg8::StaticOrder, true, true>(lds, g, S, E); }
        { pg8::Gemm g{(const bf16*)(ws + WS_PBF), (const bf16*)(ws + WS_WPPT), MT, DM, DPLE, DPLE, DPLE}; pg8::EpiGateAcc E{QK, H, nullptr, nullptr}; pg8::gemm_phase<pg8::EpiGateAcc, pg8::StaticOrder, true, true>(lds, g, S, E); }
    } SEAM(8);
    if (IN(9)) {
        const f32x4* nw = (const f32x4*)args.in[22] + lane; const int gw = vcu * NWAVES + wave, NGW = G * NWAVES;
        for (int m = gw; m < MT; m += NGW) { f32x4* xr = (f32x4*)(H + (size_t)m * DM) + lane; f32x4 v[4]; float s = 0.f;
#pragma unroll
            for (int j = 0; j < 4; ++j) { v[j] = xr[64 * j]; s += pg8::dot4(v[j]); }
            const float rs = rsqrtf(wave_sum(s) * (1.f / DM) + 1e-6f);
#pragma unroll
            for (int j = 0; j < 4; ++j) xr[64 * j] = v[j] * rs * nw[64 * j]; }
    }
#undef IN
#undef SEAM
}

extern "C" void kernel_launch(void* const* d_in, const int* in_sizes, int n_in, void* d_out, int out_size, void* d_ws, size_t ws_size, hipStream_t stream) {
    static int grid = 0;
    if (grid == 0) {
        if (n_in != 23 || ws_size < WS_END) { fprintf(stderr, "kernel_launch: unexpected inputs (n_in %d, ws %zu)\n", n_in, ws_size); grid = -1; return; }
        int dev = 0, cus = 0, per_cu = 0;
        if (hipGetDevice(&dev) != hipSuccess || hipDeviceGetAttribute(&cus, hipDeviceAttributeMultiprocessorCount, dev) != hipSuccess) { grid = -1; return; }
        if (hipFuncSetAttribute((const void*)mk_fwd, hipFuncAttributeMaxDynamicSharedMemorySize, LDS_BYTES) != hipSuccess) { fprintf(stderr, "kernel_launch: hipFuncSetAttribute failed\n"); grid = -1; return; }
        if (hipOccupancyMaxActiveBlocksPerMultiprocessor(&per_cu, (const void*)mk_fwd, NWAVES * 64, LDS_BYTES) != hipSuccess || per_cu < 1) { per_cu = 1; (void)hipGetLastError(); }
        grid = cus * 1;
    }
    if (grid < 0) return;
    Args a{};
    for (int i = 0; i < 23; ++i) a.in[i] = (const float*)d_in[i];
    a.out = (float*)d_out; a.ws = (unsigned char*)d_ws;
#if MK_SINGLE
    if (hipMemsetAsync(d_ws, 0, 65536, stream) != hipSuccess) { fprintf(stderr, "kernel_launch: hipMemsetAsync failed\n"); return; }
    a.ph_lo = 0; a.ph_hi = 10;
    void* kargs[] = {&a};
    hipError_t e = hipLaunchCooperativeKernel((const void*)mk_fwd, dim3(grid), dim3(NWAVES * 64), kargs, LDS_BYTES, stream);
    if (e != hipSuccess) fprintf(stderr, "kernel_launch: cooperative launch failed: %s (grid %d)\n", hipGetErrorString(e), grid);
#else
    for (int p = 0; p < 10; ++p) { a.ph_lo = p; a.ph_hi = p + 1; hipLaunchKernelGGL(mk_fwd, dim3(grid), dim3(NWAVES * 64), LDS_BYTES, stream, a); }
#endif
}
```
